# Optimizing an MI355X kernel written in HIP

```python
import math
import jax, jax.numpy as jnp
from jax import lax
import numpy as np

D_MODEL = 2048
BATCH = 4
SEQ = 4096
DEPTH = 2

HEAD_DIM = 128
N_HEADS_BRANCH = 4
BRANCH_WIDTH = N_HEADS_BRANCH * HEAD_DIM
N_BRANCHES = 4
MIX_WIDTH = N_BRANCHES * BRANCH_WIDTH
MLA_Q_RANK = 384
MLA_KV_RANK = 256
MLA_NOPE = 128
MLA_ROPE = 64
MLA_V = 128
ROPE_THETA = 10000.0
DILATED_PATTERNS = ((128, 1), (512, 4), (2048, 16))
IDX_HEADS = 16
IDX_DIM = 64
TOPK_MAX = 256
DIFF_QK_DIM = HEAD_DIM // 2
REL_BUCKETS = 32
REL_MAX_DIST = 2048
N_BIAS_HEADS = 3 * N_HEADS_BRANCH
Q_BLOCK = 128
NORM_EPS = 1e-6
NEG_INF = -1e30

IN_SPLITS = (
    ("a_cq", MLA_Q_RANK), ("a_ckv", MLA_KV_RANK), ("a_krope", MLA_ROPE),
    ("b_q", BRANCH_WIDTH), ("b_k", BRANCH_WIDTH), ("b_v", BRANCH_WIDTH),
    ("c_q", BRANCH_WIDTH), ("c_k", BRANCH_WIDTH), ("c_v", BRANCH_WIDTH),
    ("c_qidx", IDX_HEADS * IDX_DIM), ("c_kidx", IDX_DIM), ("c_widx", IDX_HEADS),
    ("d_q", BRANCH_WIDTH), ("d_k", BRANCH_WIDTH), ("d_v", BRANCH_WIDTH),
    ("gate", MIX_WIDTH),
)
IN_WIDTH = 3 * MLA_ROPE + MLA_Q_RANK + MLA_KV_RANK - 2 * MLA_ROPE + 9 * BRANCH_WIDTH + IDX_HEADS * IDX_DIM + IDX_DIM + IDX_HEADS + MIX_WIDTH

kernel_name = "hybrid_mla_dilated_dsa_diff_trunk"


def rmsnorm(x, g):
    xf = x.astype(jnp.float32)
    y = xf * lax.rsqrt(jnp.mean(xf * xf, axis=-1, keepdims=True) + NORM_EPS)
    return (y * g.astype(jnp.float32)).astype(x.dtype)


def split_columns(proj):
    parts, start = {}, 0
    for name, width in IN_SPLITS:
        parts[name] = proj[..., start:start + width]
        start += width
    return parts


def t5_bucket(n):
    max_exact = REL_BUCKETS // 2
    nf = jnp.maximum(n, max_exact).astype(jnp.float32)
    large = max_exact + (jnp.log(nf / max_exact) / math.log(REL_MAX_DIST / max_exact)
                         * (REL_BUCKETS - max_exact)).astype(jnp.int32)
    large = jnp.minimum(large, REL_BUCKETS - 1)
    return jnp.where(n < max_exact, n, large)


def apply_rope(x, pos):
    half = x.shape[-1] // 2
    inv = ROPE_THETA ** (-jnp.arange(half, dtype=jnp.float32) / half)
    ang = pos.astype(jnp.float32)[:, None] * inv[None, :]
    cos = jnp.cos(ang)[None, :, None, :].astype(x.dtype)
    sin = jnp.sin(ang)[None, :, None, :].astype(x.dtype)
    x1, x2 = x[..., :half], x[..., half:]
    return jnp.concatenate([x1 * cos - x2 * sin, x2 * cos + x1 * sin], axis=-1)


def to_blocks(t):
    b, s = t.shape[:2]
    return jnp.swapaxes(t.reshape((b, s // Q_BLOCK, Q_BLOCK) + t.shape[2:]), 0, 1)


def from_blocks(t):
    t = jnp.swapaxes(t, 0, 1)
    return t.reshape((t.shape[0], t.shape[1] * t.shape[2]) + t.shape[3:])


def causal_block_attention(q, k, v, scale):
    s = q.shape[1]
    kpos = jnp.arange(s)

    def one_block(args):
        q_blk, bi = args
        qpos = bi * Q_BLOCK + jnp.arange(Q_BLOCK)
        logits = jnp.einsum('bqhd,bshd->bqhs', q_blk, k).astype(jnp.float32) * scale
        logits = jnp.where((kpos[None, :] <= qpos[:, None])[None, :, None, :], logits, NEG_INF)
        p = jax.nn.softmax(logits, axis=-1).astype(v.dtype)
        return jnp.einsum('bqhs,bshd->bqhd', p, v)

    out = lax.map(one_block, (to_blocks(q), jnp.arange(s // Q_BLOCK)))
    return from_blocks(out)


def dilated_mixture_attention(q, k, v, bias_tab):
    s, dh = q.shape[1], q.shape[-1]
    scale = dh ** -0.5
    patterns = []
    for window, dil in DILATED_PATTERNS:
        offs = dil * jnp.arange(window // dil + 1)
        bias = bias_tab[t5_bucket(offs)].T
        patterns.append((offs, bias))

    def one_block(args):
        q_blk, bi = args
        qpos = bi * Q_BLOCK + jnp.arange(Q_BLOCK)
        lses, outs = [], []
        for offs, bias in patterns:
            kidx = qpos[:, None] - offs[None, :]
            valid = kidx >= 0
            kidx = jnp.maximum(kidx, 0)
            k_g = k[:, kidx]
            v_g = v[:, kidx]
            logits = jnp.einsum('bqhd,bqnhd->bqhn', q_blk, k_g).astype(jnp.float32) * scale
            logits = logits + bias.astype(jnp.float32)[None, None]
            logits = jnp.where(valid[None, :, None, :], logits, NEG_INF)
            lse = jax.nn.logsumexp(logits, axis=-1)
            p = jnp.exp(logits - lse[..., None]).astype(v.dtype)
            outs.append(jnp.einsum('bqhn,bqnhd->bqhd', p, v_g))
            lses.append(lse)
        wts = jax.nn.softmax(jnp.stack(lses, axis=-1), axis=-1).astype(v.dtype)
        return sum(wts[..., g, None] * outs[g] for g in range(len(outs)))

    out = lax.map(one_block, (to_blocks(q), jnp.arange(s // Q_BLOCK)))
    return from_blocks(out)


def dsa_attention(q, k, v, q_idx, k_idx, w_idx, bias_tab):
    s, dh = q.shape[1], q.shape[-1]
    scale = dh ** -0.5
    n_sel = min(TOPK_MAX, s // 4)
    kpos = jnp.arange(s)

    def one_block(args):
        q_blk, qi_blk, wi_blk, bi = args
        qpos = bi * Q_BLOCK + jnp.arange(Q_BLOCK)
        causal = kpos[None, :] <= qpos[:, None]
        dots = jnp.einsum('bqhd,bsd->bqhs', qi_blk, k_idx).astype(jnp.float32) * IDX_DIM ** -0.5
        score = jnp.einsum('bqhs,bqh->bqs', jax.nn.relu(dots),
                           wi_blk.astype(jnp.float32) * IDX_HEADS ** -0.5)
        score = jnp.where(causal[None], score, NEG_INF)
        _, sel = lax.top_k(score, n_sel)
        valid = sel <= qpos[None, :, None]
        k_sel = jax.vmap(lambda kb, ib: kb[ib])(k, sel)
        v_sel = jax.vmap(lambda vb, ib: vb[ib])(v, sel)
        bias = bias_tab[t5_bucket(jnp.maximum(qpos[None, :, None] - sel, 0))]
        logits = jnp.einsum('bqhd,bqkhd->bqhk', q_blk, k_sel).astype(jnp.float32) * scale
        logits = logits + jnp.transpose(bias, (0, 1, 3, 2)).astype(jnp.float32)
        logits = jnp.where(valid[:, :, None, :], logits, NEG_INF)
        p = jax.nn.softmax(logits, axis=-1).astype(v.dtype)
        return jnp.einsum('bqhk,bqkhd->bqhd', p, v_sel)

    out = lax.map(one_block, (to_blocks(q), to_blocks(q_idx), to_blocks(w_idx),
                              jnp.arange(s // Q_BLOCK)))
    return from_blocks(out)


def diff_attention(q1, q2, k1, k2, v, lam, bias_tab):
    s, dq = q1.shape[1], q1.shape[-1]
    scale = dq ** -0.5
    kpos = jnp.arange(s)

    def one_block(args):
        q1b, q2b, bi = args
        qpos = bi * Q_BLOCK + jnp.arange(Q_BLOCK)
        causal = (kpos[None, :] <= qpos[:, None])[None, :, None, :]
        rel = jnp.maximum(qpos[:, None] - kpos[None, :], 0)
        bias = jnp.transpose(bias_tab[t5_bucket(rel)], (0, 2, 1))[None].astype(jnp.float32)
        l1 = jnp.einsum('bqhd,bshd->bqhs', q1b, k1).astype(jnp.float32) * scale + bias
        l2 = jnp.einsum('bqhd,bshd->bqhs', q2b, k2).astype(jnp.float32) * scale + bias
        p1 = jax.nn.softmax(jnp.where(causal, l1, NEG_INF), axis=-1)
        p2 = jax.nn.softmax(jnp.where(causal, l2, NEG_INF), axis=-1)
        a = (p1 - lam * p2).astype(v.dtype)
        return jnp.einsum('bqhs,bshd->bqhd', a, v)

    out = lax.map(one_block, (to_blocks(q1), to_blocks(q2), jnp.arange(s // Q_BLOCK)))
    return from_blocks(out)


def setup_inputs(seed: int = 0) -> dict:
    key = jax.random.key(seed)
    ks = jax.random.split(key, 20)
    f32 = jnp.float32

    def nrm(k, shape, s):
        return jax.random.normal(k, shape, f32) * s

    def gain(k, shape):
        return 1.0 + 0.05 * jax.random.normal(k, shape, f32)

    return {
        "x": nrm(ks[0], (BATCH, SEQ, D_MODEL), 1.0),
        "c": nrm(ks[1], (BATCH, D_MODEL), 1.0),
        "w_ada": nrm(ks[2], (DEPTH, D_MODEL, 3 * D_MODEL), 0.5 * D_MODEL ** -0.5),
        "b_ada": nrm(ks[3], (DEPTH, 3 * D_MODEL), 0.02),
        "g_pre": gain(ks[4], (DEPTH, D_MODEL)),
        "g_post": gain(ks[5], (DEPTH, D_MODEL)),
        "w_in": nrm(ks[6], (DEPTH, D_MODEL, IN_WIDTH), D_MODEL ** -0.5),
        "g_q_a": gain(ks[7], (DEPTH, MLA_Q_RANK)),
        "w_uq_a": nrm(ks[8], (DEPTH, MLA_Q_RANK, N_HEADS_BRANCH * (MLA_NOPE + MLA_ROPE)), MLA_Q_RANK ** -0.5),
        "g_kv_a": gain(ks[9], (DEPTH, MLA_KV_RANK)),
        "w_ukv_a": nrm(ks[10], (DEPTH, MLA_KV_RANK, N_HEADS_BRANCH * (MLA_NOPE + MLA_V)), MLA_KV_RANK ** -0.5),
        "lam_q1": nrm(ks[11], (DEPTH, DIFF_QK_DIM), 0.1),
        "lam_k1": nrm(ks[12], (DEPTH, DIFF_QK_DIM), 0.1),
        "lam_q2": nrm(ks[13], (DEPTH, DIFF_QK_DIM), 0.1),
        "lam_k2": nrm(ks[14], (DEPTH, DIFF_QK_DIM), 0.1),
        "g_sub_d": gain(ks[15], (DEPTH, HEAD_DIM)),
        "w_out": nrm(ks[16], (DEPTH, MIX_WIDTH, D_MODEL), MIX_WIDTH ** -0.5),
        "rel_bias": nrm(ks[17], (REL_BUCKETS, N_BIAS_HEADS), 0.5),
    }


def reference(x, c, w_ada, b_ada, g_pre, g_post, w_in, g_q_a, w_uq_a, g_kv_a, w_ukv_a,
              lam_q1, lam_k1, lam_q2, lam_k2, g_sub_d, w_out, rel_bias):
    b, s, _ = x.shape
    nh = N_HEADS_BRANCH
    pos = jnp.arange(s)

    def heads(t):
        return t.reshape(b, s, nh, -1)

    for li in range(DEPTH):
        mod = jax.nn.silu(c) @ w_ada[li] + b_ada[li]
        shift, scale, gate = jnp.split(mod, 3, axis=-1)
        h = rmsnorm(x, g_pre[li]) * (1.0 + scale[:, None, :]) + shift[:, None, :]
        p = split_columns(h @ w_in[li])

        q_a = (rmsnorm(p["a_cq"], g_q_a[li]) @ w_uq_a[li]).reshape(b, s, nh, MLA_NOPE + MLA_ROPE)
        kv_a = (rmsnorm(p["a_ckv"], g_kv_a[li]) @ w_ukv_a[li]).reshape(b, s, nh, MLA_NOPE + MLA_V)
        q_a = jnp.concatenate([q_a[..., :MLA_NOPE], apply_rope(q_a[..., MLA_NOPE:], pos)], axis=-1)
        k_rope = apply_rope(p["a_krope"][:, :, None, :], pos)
        k_a = jnp.concatenate([kv_a[..., :MLA_NOPE],
                               jnp.broadcast_to(k_rope, (b, s, nh, MLA_ROPE))], axis=-1)
        out_a = causal_block_attention(q_a, k_a, kv_a[..., MLA_NOPE:], (MLA_NOPE + MLA_ROPE) ** -0.5)

        out_b = dilated_mixture_attention(heads(p["b_q"]), heads(p["b_k"]), heads(p["b_v"]),
                                          rel_bias[:, 0:nh])

        out_c = dsa_attention(heads(p["c_q"]), heads(p["c_k"]), heads(p["c_v"]),
                              p["c_qidx"].reshape(b, s, IDX_HEADS, IDX_DIM), p["c_kidx"], p["c_widx"],
                              rel_bias[:, nh:2 * nh])

        lam_init = 0.8 - 0.6 * math.exp(-0.3 * li)
        lam = (jnp.exp(jnp.sum(lam_q1[li] * lam_k1[li]).astype(jnp.float32))
               - jnp.exp(jnp.sum(lam_q2[li] * lam_k2[li]).astype(jnp.float32)) + lam_init)
        q_d, k_d = heads(p["d_q"]), heads(p["d_k"])
        out_d = diff_attention(q_d[..., :DIFF_QK_DIM], q_d[..., DIFF_QK_DIM:],
                               k_d[..., :DIFF_QK_DIM], k_d[..., DIFF_QK_DIM:],
                               heads(p["d_v"]), lam, rel_bias[:, 2 * nh:3 * nh])
        out_d = rmsnorm(out_d, g_sub_d[li]) * (1.0 - lam_init)

        mixed = jnp.concatenate([o.reshape(b, s, BRANCH_WIDTH) for o in (out_a, out_b, out_c, out_d)],
                                axis=-1) * jax.nn.silu(p["gate"])
        y = mixed @ w_out[li]
        x = x + gate[:, None, :] * rmsnorm(y, g_post[li])
    return x
```

```cpp
#include <hip/hip_runtime.h>
#include <cstdio>
#include <cstdint>
constexpr int M = 16384, NW1 = 8704;
constexpr size_t al256(size_t x) { return (x + 255) & ~(size_t)255; }
constexpr size_t WS_CTL = 0;
constexpr size_t CTL_BYTES = 65536;
constexpr size_t WS_MOD = WS_CTL + CTL_BYTES;
constexpr size_t WS_SSQ = WS_MOD + al256(2 * 4 * 6144 * 4);
constexpr size_t WS_SSKV = WS_SSQ + (size_t)M * 8 * 4;
constexpr size_t WS_SSEND = WS_SSKV + (size_t)M * 4 * 4;
constexpr size_t ZERO_BYTES = CTL_BYTES;
constexpr size_t WS_CONST = WS_SSEND;
constexpr size_t WS_ROPE = WS_CONST + 256;
constexpr size_t WS_TCD = WS_ROPE + (size_t)4096 * 32 * 8;
constexpr size_t WS_TB = WS_TCD + (size_t)8 * 4096 * 4;
constexpr size_t WS_WTOUT = WS_TB + (size_t)4 * 2560 * 4;
constexpr size_t WS_WTUQ = WS_WTOUT + (size_t)2 * 2048 * 2048 * 2;
constexpr size_t WS_WTUKV = WS_WTUQ + (size_t)2 * 768 * 384 * 2;
constexpr size_t WTIN_BYTES = (size_t)NW1 * 2048 * 2;
constexpr size_t WS_WTIN1 = WS_WTUKV + (size_t)2 * 1024 * 256 * 2;
constexpr size_t WS_WTIN0 = WS_WTIN1 + WTIN_BYTES;
constexpr size_t WS_H = WS_WTIN0 + WTIN_BYTES;
constexpr size_t WS_SCR = WS_WTIN0;
constexpr size_t SCR_BYTES = WTIN_BYTES + (size_t)M * 2048 * 2;
static_assert((size_t)16384 * 6176 <= SCR_BYTES, "indexer scratch: 256 compact slots");
constexpr size_t WS_MIXED = WS_H + (size_t)M * 2048 * 2;
constexpr size_t WS_CKV = WS_MIXED + (size_t)M * 2048 * 2;
constexpr size_t WS_CQ = WS_CKV + (size_t)M * 256 * 2;
constexpr size_t WS_KR = WS_CQ + (size_t)M * 384 * 2;
constexpr size_t WS_IDXK = WS_KR + (size_t)M * 64 * 2;
constexpr size_t WS_IDXW = WS_IDXK + (size_t)M * 64 * 2;
constexpr size_t WS_IDXQ = WS_IDXW + (size_t)M * 16 * 4;
constexpr size_t WS_QKV = WS_IDXQ + (size_t)M * 1024 * 2;
constexpr size_t WS_QA = WS_QKV + (size_t)9 * M * 512 * 2;
constexpr size_t WS_KVA = WS_QA + (size_t)M * 768 * 2;
constexpr size_t WS_BM = WS_KVA + (size_t)M * 1024 * 2;
constexpr size_t WS_PB = WS_BM + (size_t)M * 64 * 8;
constexpr size_t WS_LSE = WS_PB + (size_t)2 * M * 512 * 2;
constexpr size_t WS_END = WS_LSE + (size_t)2 * M * 4 * 4;
constexpr size_t WS_Y = WS_QKV;
static_assert((size_t)M * 2048 * 4 <= (size_t)9 * M * 512 * 2, "Y overlay");

namespace pg8 { constexpr size_t OFF_CKV = WS_CKV, OFF_CQ = WS_CQ, OFF_KR = WS_KR, OFF_IDXK = WS_IDXK, OFF_IDXQ = WS_IDXQ, OFF_QKV = WS_QKV, OFF_MIXED = WS_MIXED, OFF_IDXW = WS_IDXW,
    OFF_SSQ = WS_SSQ, OFF_SSKV = WS_SSKV, OFF_ROPE = WS_ROPE, OFF_QA = WS_QA, OFF_KVA = WS_KVA, OFF_Y = WS_Y; }
__device__ __forceinline__ int fresh_lane() { unsigned ones = ~0u; asm volatile("" : "+s"(ones)); return (int)__builtin_amdgcn_mbcnt_hi(ones, __builtin_amdgcn_mbcnt_lo(ones, 0u)); }
namespace pg8 {
#define PG8_LAS __attribute__((address_space(3)))
typedef unsigned short bf16_t;
typedef short bf16x8 __attribute__((ext_vector_type(8)));
typedef float f32x4 __attribute__((ext_vector_type(4)));
typedef unsigned u32x4 __attribute__((ext_vector_type(4)));
constexpr int BM = 256, BK = 64, HALF = 128, HTB = HALF * BK * 2  , STAGE_BYTES = 8 * HTB, NXCD = 8, WGM = 8;

__host__ __device__ __forceinline__ int lds_byte(int r, int c) { const int st = (r >> 4) * 2 + (c >> 5), rr = r & 15, cc = c & 31, ob = rr * 64 + cc * 2; return st * 1024 + (ob ^ (((ob >> 9) & 1) << 5)); }
__host__ __device__ __forceinline__ void stage_rc(int b, int& R, int& C) { const int st = b / 1024, sb = b % 1024, swz = sb ^ (((sb >> 9) & 1) << 5); R = (st >> 1) * 16 + swz / 64; C = (st & 1) * 32 + (swz % 64) / 2; }
__host__ __device__ __forceinline__ int perm32(int rho) { const int n = rho >> 4, i = rho & 15; return 8 * (i >> 2) + 4 * n + (i & 3); }

struct Unit { int pm, pn, hs; };
struct Gemm { const bf16_t* A; const bf16_t* Bt; int M, N, K; };

struct StaticOrder {
    int nM, nN, nwg, G, c;
    __host__ __device__ void init(int M, int N, int G_, int c_) { nM = M / BM; nN = N / BM; nwg = nM * nN; G = G_; c = c_; }
    __host__ __device__ bool next(int i, Unit& u) const {
        const long L = (long)i * G + c; if (L >= nwg) return false;
        int wgid = (int)L; { const int q = nwg / NXCD, r = nwg % NXCD, xcd = wgid % NXCD, off = wgid / NXCD; wgid = (xcd < r ? xcd * (q + 1) : r * (q + 1) + (xcd - r) * q) + off; }
        const int nig = WGM * nN, gid = wgid / nig, fm = gid * WGM, gsz = (nM - fm) < WGM ? (nM - fm) : WGM;
        u.pm = fm + ((wgid % nig) % gsz); u.pn = ((wgid % nig) / gsz + 4 * gid) % nN; u.hs = 0; return true;
    }
    __device__ __forceinline__ void a_ready(const Unit&) const {}
    __device__ __forceinline__ void done(const Unit&) const {}
};
struct TailOrder {
    int c;
    __device__ __forceinline__ bool next(int i, Unit& u) const { if (i > 0) return false; const int g = c & 7, w = c >> 3; u.pm = 8 * g + ((w >> 1) & 7); u.pn = 32 + (w >> 4); u.hs = w & 1; return true; }
    __device__ __forceinline__ void a_ready(const Unit&) const {}
    __device__ __forceinline__ void done(const Unit&) const {}
};

__device__ __forceinline__ unsigned cvt_pk_bf16(float lo, float hi) { unsigned r; asm volatile("v_cvt_pk_bf16_f32 %0, %1, %2" : "=v"(r) : "v"(lo), "v"(hi)); return r; }
typedef float f32x2 __attribute__((ext_vector_type(2)));
__device__ __forceinline__ float silu_f(float v) { return v * __builtin_amdgcn_rcpf(1.0f + __builtin_amdgcn_exp2f(-1.4426950408889634f * v)); }
__device__ __forceinline__ u32x4 pack8bf(const f32x4& a, const f32x4& b) { u32x4 w; w.x = cvt_pk_bf16(a[0], a[1]); w.y = cvt_pk_bf16(a[2], a[3]); w.z = cvt_pk_bf16(b[0], b[1]); w.w = cvt_pk_bf16(b[2], b[3]); return w; }

enum { EM_PLAIN = 0, EM_SILU = 1, EM_ROPE = 2 };
template <int MODE>
__device__ __forceinline__ void epi_rows(const f32x4 (&acc)[2][2][4][2], int bj, bf16_t* dst, int pitch, int row0, int fq, float scale_unused, const f32x2* rope_m0  ) {
#pragma unroll
    for (int ai = 0; ai < 2; ++ai)
#pragma unroll
        for (int m = 0; m < 4; ++m) {
            const int row = row0 + ai * HALF + m * 16;
            f32x4 v0 = acc[ai][bj][m][0], v1 = acc[ai][bj][m][1];
            if (MODE == EM_SILU) {
#pragma unroll
                for (int e = 0; e < 4; ++e) { v0[e] = silu_f(v0[e]); v1[e] = silu_f(v1[e]); }
            }
            if (MODE == EM_ROPE) {
                const f32x2* cs = rope_m0 + (row & 4095) * 32;
                const f32x2 c0_ = cs[0], c1_ = cs[1], c2_ = cs[2], c3_ = cs[3];
                f32x4 r0, r1;
                r0[0] = v0[0] * c0_.x - v0[1] * c0_.y; r0[1] = v0[1] * c0_.x + v0[0] * c0_.y;
                r0[2] = v0[2] * c1_.x - v0[3] * c1_.y; r0[3] = v0[3] * c1_.x + v0[2] * c1_.y;
                r1[0] = v1[0] * c2_.x - v1[1] * c2_.y; r1[1] = v1[1] * c2_.x + v1[0] * c2_.y;
                r1[2] = v1[2] * c3_.x - v1[3] * c3_.y; r1[3] = v1[3] * c3_.x + v1[2] * c3_.y;
                v0 = r0; v1 = r1;
            }
            *(u32x4*)(dst + (size_t)row * pitch + 8 * fq) = pack8bf(v0, v1);
        }
}
template <int NBJ>
__device__ __forceinline__ void epi_ss(const f32x4 (&acc)[2][2][4][2], float* ss, int stride, int slot, int row0, int fq) {
#pragma unroll
    for (int ai = 0; ai < 2; ++ai)
#pragma unroll
        for (int m = 0; m < 4; ++m) {
            float s = 0.f;
#pragma unroll
            for (int bj = 0; bj < NBJ; ++bj) { const f32x4 v0 = acc[ai][bj][m][0], v1 = acc[ai][bj][m][1];
                s += (v0[0] * v0[0] + v0[1] * v0[1]) + (v0[2] * v0[2] + v0[3] * v0[3]) + (v1[0] * v1[0] + v1[1] * v1[1]) + (v1[2] * v1[2] + v1[3] * v1[3]); }
            s += __shfl_xor(s, 16); s += __shfl_xor(s, 32);
            if (fq == 0) ss[(size_t)(row0 + ai * HALF + m * 16) * stride + slot] = s;
        }
}
struct EpiIn {
    static constexpr bool PERM = true, AFTER_DRAIN = false;
    unsigned char* ws;
    __device__ __forceinline__ void operator()(const f32x4 (&acc)[2][2][4][2], const Unit& u, int wr, int wc, int fr, int fq) const {
        const int pn = u.pn;
        const int row0 = u.pm * BM + wr * 64 + fr;
        const int cw = wc * 32;
        if (pn >= 26) {
            bf16_t* d = (bf16_t*)(ws + OFF_MIXED) + (pn - 26) * 256 + cw;
            epi_rows<EM_SILU>(acc, 0, d, 2048, row0, fq, 0.f, nullptr); epi_rows<EM_SILU>(acc, 1, d + HALF, 2048, row0, fq, 0.f, nullptr);
        } else if (pn >= 8) {
            bf16_t* d = (bf16_t*)(ws + OFF_QKV) + (size_t)((pn - 8) >> 1) * (16384 * 512) + ((pn - 8) & 1) * 256 + cw;
            epi_rows<EM_PLAIN>(acc, 0, d, 512, row0, fq, 0.f, nullptr); epi_rows<EM_PLAIN>(acc, 1, d + HALF, 512, row0, fq, 0.f, nullptr);
        } else if (pn >= 4) {
            bf16_t* d = (bf16_t*)(ws + OFF_IDXQ) + (pn - 4) * 256 + cw;
            epi_rows<EM_PLAIN>(acc, 0, d, 1024, row0, fq, 0.f, nullptr); epi_rows<EM_PLAIN>(acc, 1, d + HALF, 1024, row0, fq, 0.f, nullptr);
        } else if (pn == 0) {
            bf16_t* d = (bf16_t*)(ws + OFF_CKV) + cw;
            epi_rows<EM_PLAIN>(acc, 0, d, 256, row0, fq, 0.f, nullptr); epi_rows<EM_PLAIN>(acc, 1, d + HALF, 256, row0, fq, 0.f, nullptr);
            epi_ss<2>(acc, (float*)(ws + OFF_SSKV), 4, wc, row0, fq);
        } else if (pn == 1) {
            bf16_t* d = (bf16_t*)(ws + OFF_CQ) + cw;
            epi_rows<EM_PLAIN>(acc, 0, d, 384, row0, fq, 0.f, nullptr); epi_rows<EM_PLAIN>(acc, 1, d + HALF, 384, row0, fq, 0.f, nullptr);
            epi_ss<2>(acc, (float*)(ws + OFF_SSQ), 8, wc, row0, fq);
        } else if (pn == 2) {
            epi_rows<EM_PLAIN>(acc, 0, (bf16_t*)(ws + OFF_CQ) + 256 + cw, 384, row0, fq, 0.f, nullptr);
            epi_ss<1>(acc, (float*)(ws + OFF_SSQ), 8, 4 + wc, row0, fq);
            if (wc < 2) epi_rows<EM_ROPE>(acc, 1, (bf16_t*)(ws + OFF_KR) + cw, 64, row0, fq, 0.f, (const f32x2*)(ws + OFF_ROPE) + 16 * wc + 4 * fq);
            else        epi_rows<EM_PLAIN>(acc, 1, (bf16_t*)(ws + OFF_IDXK) + (cw - 64), 64, row0, fq, 0.f, nullptr);
        } else {
            if (wc == 0 && fq < 2) {
                float* d = (float*)(ws + OFF_IDXW) + 8 * fq;
#pragma unroll
                for (int ai = 0; ai < 2; ++ai)
#pragma unroll
                    for (int m = 0; m < 4; ++m) { float* p = d + (size_t)(row0 + ai * HALF + m * 16) * 16; *(f32x4*)p = acc[ai][0][m][0] * 0.03125f; *(f32x4*)(p + 4) = acc[ai][0][m][1] * 0.03125f; }
            }
        }
    }
};

struct EpiTail {
    static constexpr bool PERM = true, AFTER_DRAIN = false;
    unsigned char* ws;
    __device__ __forceinline__ void operator()(const f32x4 (&acc)[2][2][4][2], const Unit& u, int wr, int wc, int fr, int fq) const {
        const int row0 = u.pm * BM + u.hs * HALF + wr * 64 + fr;
        bf16_t* d = (bf16_t*)(ws + OFF_MIXED) + (u.pn - 26) * 256 + wc * 32;
#pragma unroll
        for (int bj = 0; bj < 2; ++bj)
#pragma unroll
            for (int m = 0; m < 4; ++m) {
                f32x4 v0 = acc[0][bj][m][0], v1 = acc[0][bj][m][1];
#pragma unroll
                for (int e = 0; e < 4; ++e) { v0[e] = silu_f(v0[e]); v1[e] = silu_f(v1[e]); }
                *(u32x4*)(d + bj * HALF + (size_t)(row0 + m * 16) * 2048 + 8 * fq) = pack8bf(v0, v1);
            }
    }
};

struct EpiQ {
    static constexpr bool PERM = true, AFTER_DRAIN = false;
    unsigned char* ws;
    __device__ __forceinline__ void operator()(const f32x4 (&acc)[2][2][4][2], const Unit& u, int wr, int wc, int fr, int fq) const {
        bf16_t* const QA = (bf16_t*)(ws + OFF_QA); const float* const SSQ = (const float*)(ws + OFF_SSQ);
        const int row0 = u.pm * BM + wr * 64 + fr;
        const int cb0 = u.pn * BM + wc * 32, cb1 = cb0 + HALF;
        const int ib0 = cb0 % 192, ib1 = cb1 % 192;
        const bool rp0 = ib0 >= 128, rp1 = ib1 >= 128;
        const f32x2* const rt0 = (const f32x2*)(ws + OFF_ROPE) + ((ib0 - 128) >> 1) + 4 * fq;
        const f32x2* const rt1 = (const f32x2*)(ws + OFF_ROPE) + ((ib1 - 128) >> 1) + 4 * fq;
#pragma unroll
        for (int ai = 0; ai < 2; ++ai)
#pragma unroll
            for (int m = 0; m < 4; ++m) {
                const int row = row0 + ai * HALF + m * 16;
                const f32x4 sa = *(const f32x4*)(SSQ + (size_t)row * 8), sb = *(const f32x4*)(SSQ + (size_t)row * 8 + 4);
                const float rs = __builtin_amdgcn_rsqf((((sa[0] + sa[1]) + (sa[2] + sa[3])) + ((sb[0] + sb[1]) + (sb[2] + sb[3]))) * (1.0f / 384.0f) + 1e-6f);
#pragma unroll
                for (int bj = 0; bj < 2; ++bj) {
                    f32x4 v0 = acc[ai][bj][m][0] * rs, v1 = acc[ai][bj][m][1] * rs;
                    if (bj == 0 ? rp0 : rp1) {
                        const f32x2* cs = (bj == 0 ? rt0 : rt1) + (row & 4095) * 32;
                        const f32x2 c0_ = cs[0], c1_ = cs[1], c2_ = cs[2], c3_ = cs[3];
                        f32x4 r0, r1;
                        r0[0] = v0[0] * c0_.x - v0[1] * c0_.y; r0[1] = v0[1] * c0_.x + v0[0] * c0_.y;
                        r0[2] = v0[2] * c1_.x - v0[3] * c1_.y; r0[3] = v0[3] * c1_.x + v0[2] * c1_.y;
                        r1[0] = v1[0] * c2_.x - v1[1] * c2_.y; r1[1] = v1[1] * c2_.x + v1[0] * c2_.y;
                        r1[2] = v1[2] * c3_.x - v1[3] * c3_.y; r1[3] = v1[3] * c3_.x + v1[2] * c3_.y;
                        v0 = r0; v1 = r1;
                    }
                    *(u32x4*)(QA + (size_t)row * 768 + (bj == 0 ? cb0 : cb1) + 8 * fq) = pack8bf(v0, v1);
                }
            }
    }
};
struct EpiKV {
    static constexpr bool PERM = true, AFTER_DRAIN = false;
    unsigned char* ws;
    __device__ __forceinline__ void operator()(const f32x4 (&acc)[2][2][4][2], const Unit& u, int wr, int wc, int fr, int fq) const {
        bf16_t* const KVA = (bf16_t*)(ws + OFF_KVA); const float* const SSKV = (const float*)(ws + OFF_SSKV);
        const int row0 = u.pm * BM + wr * 64 + fr;
#pragma unroll
        for (int ai = 0; ai < 2; ++ai)
#pragma unroll
            for (int m = 0; m < 4; ++m) {
                const int row = row0 + ai * HALF + m * 16;
                const f32x4 sa = *(const f32x4*)(SSKV + (size_t)row * 4);
                const float rs = __builtin_amdgcn_rsqf(((sa[0] + sa[1]) + (sa[2] + sa[3])) * (1.0f / 256.0f) + 1e-6f);
#pragma unroll
                for (int bj = 0; bj < 2; ++bj) {
                    const int c0 = u.pn * BM + bj * HALF + wc * 32 + 8 * fq;
                    *(u32x4*)(KVA + (size_t)row * 1024 + c0) = pack8bf(acc[ai][bj][m][0] * rs, acc[ai][bj][m][1] * rs);
                }
            }
    }
};
struct EpiY {
    static constexpr bool PERM = true, AFTER_DRAIN = false;
    unsigned char* ws;
    __device__ __forceinline__ void operator()(const f32x4 (&acc)[2][2][4][2], const Unit& u, int wr, int wc, int fr, int fq) const {
        bf16_t* d = (bf16_t*)(ws + OFF_Y) + u.pn * BM + wc * 32;
        const int row0 = u.pm * BM + wr * 64 + fr;
        epi_rows<EM_PLAIN>(acc, 0, d, 2048, row0, fq, 0.f, nullptr); epi_rows<EM_PLAIN>(acc, 1, d + HALF, 2048, row0, fq, 0.f, nullptr);
    }
};
template <class Epi, class Sched, bool ALIGN_EPI = false, bool SP2 = false, bool HALFM = false>
__device__ __forceinline__ void gemm_phase(PG8_LAS unsigned char* lds, const Gemm g, const Sched& S, const Epi& E, int wave_in  ) {
    int tid_ = wave_in * 64 + fresh_lane(); asm volatile("" : "+v"(tid_));
    const int tid = tid_, wid = __builtin_amdgcn_readfirstlane(tid >> 6), lane = tid & 63, wr = wid >> 2, wc = wid & 3, fr = lane & 15, fq = lane >> 4;
    int K_ = g.K; asm volatile("" : "+s"(K_));
    const int K = K_, nt = K / BK;
    unsigned voffA[2], voffB[2];
#pragma unroll
    for (int i = 0; i < 2; ++i) { int R, C; stage_rc(tid * 16 + i * 8192, R, C); const int Rb = Epi::PERM ? ((R & ~31) + perm32(R & 31)) : R;
        voffA[i] = (unsigned)(R * K + C) * 2u; voffB[i] = (unsigned)(Rb * K + C) * 2u; }
    const size_t kstep = (size_t)(BK * 2);
    const size_t hstep = (size_t)HALF * K * 2;
    const size_t tstep = 2 * hstep;
    const size_t hstepA = HALFM ? (size_t)0 : hstep;
    static_assert(!HALFM || SP2, "HALFM needs the SP2 loop");
    const unsigned ldsw = (unsigned)wid * 1024u;
    const int aoff = lds_byte(wr * 64 + fr, fq * 8), boff = lds_byte(wc * 32 + fr, fq * 8);
#define PG8_SA(b, h) (((b) * 2 + (h)) * HTB)
#define PG8_SB(b, h) ((4 + (b) * 2 + (h)) * HTB)
#define PG8_STAGE(bufoff, gbase, voff) do { _Pragma("unroll") for (int _i = 0; _i < 2; ++_i) \
        __builtin_amdgcn_global_load_lds((const unsigned*)((const char*)(gbase) + (voff)[_i]), (PG8_LAS unsigned*)(lds + (bufoff) + ldsw + _i * 8192), 16, 0, 0); } while (0)
#define PG8_LDA(dst, b, h) do { _Pragma("unroll") for (int m = 0; m < 4; ++m) _Pragma("unroll") for (int k = 0; k < 2; ++k) dst[m][k] = *(const PG8_LAS bf16x8*)(lds + PG8_SA(b, h) + aoff + m * 2048 + k * 1024); } while (0)
#define PG8_LDB(dst, b, h) do { _Pragma("unroll") for (int n = 0; n < 2; ++n) _Pragma("unroll") for (int k = 0; k < 2; ++k) dst[n][k] = *(const PG8_LAS bf16x8*)(lds + PG8_SB(b, h) + boff + n * 2048 + k * 1024); } while (0)
#define PG8_MMA(ai, bj, At, Bt) do { __builtin_amdgcn_s_setprio(1); _Pragma("unroll") for (int m = 0; m < 4; ++m) _Pragma("unroll") for (int n = 0; n < 2; ++n) _Pragma("unroll") for (int k = 0; k < 2; ++k) \
        acc[ai][bj][m][n] = __builtin_amdgcn_mfma_f32_16x16x32_bf16(Bt[n][k], At[m][k], acc[ai][bj][m][n], 0, 0, 0); __builtin_amdgcn_s_setprio(0); } while (0)
#define PG8_WAIT_V(n) asm volatile("s_waitcnt vmcnt(" #n ")" ::: "memory")
#define PG8_WAIT_L(n) asm volatile("s_waitcnt lgkmcnt(" #n ")" ::: "memory")
#define PG8_BAR __builtin_amdgcn_s_barrier()
#define PG8_SCHED __builtin_amdgcn_sched_barrier(0)
    Unit cur, nxt; int ui = 0;
    if (!S.next(0, cur)) return;
    f32x4 acc[2][2][4][2];
#pragma unroll
    for (int a = 0; a < 2; ++a)
#pragma unroll
        for (int b = 0; b < 2; ++b)
#pragma unroll
            for (int m = 0; m < 4; ++m)
#pragma unroll
                for (int n = 0; n < 2; ++n) acc[a][b][m][n] = (f32x4){0.f, 0.f, 0.f, 0.f};
    bf16x8 At[4][2], B0[2][2], B1[2][2];
    const char* cA = (const char*)g.A + (size_t)cur.pm * tstep + (HALFM ? (size_t)cur.hs * hstep : (size_t)0); const char* cB = (const char*)g.Bt + (size_t)cur.pn * tstep;
    S.a_ready(cur);
    if constexpr (SP2) {
        PG8_STAGE(PG8_SB(0, 0), cB, voffB); PG8_STAGE(PG8_SB(0, 1), cB + hstep, voffB); PG8_STAGE(PG8_SA(0, 0), cA, voffA); PG8_STAGE(PG8_SA(0, 1), cA + hstepA, voffA);
        if (wr == 1) PG8_BAR;
        PG8_WAIT_V(2); PG8_BAR;
        PG8_STAGE(PG8_SB(1, 0), cB + kstep, voffB); PG8_STAGE(PG8_SA(1, 0), cA + kstep, voffA); PG8_STAGE(PG8_SB(1, 1), cB + hstep + kstep, voffB);
        PG8_WAIT_V(6); PG8_BAR;
    } else {
        PG8_STAGE(PG8_SB(0, 0), cB, voffB); PG8_STAGE(PG8_SA(0, 0), cA, voffA); PG8_STAGE(PG8_SB(0, 1), cB + hstep, voffB); PG8_STAGE(PG8_SA(0, 1), cA + hstep, voffA);
        if (wr == 1) PG8_BAR;
        PG8_WAIT_V(4); PG8_BAR;
        PG8_STAGE(PG8_SB(1, 0), cB + kstep, voffB); PG8_STAGE(PG8_SA(1, 0), cA + kstep, voffA); PG8_STAGE(PG8_SB(1, 1), cB + hstep + kstep, voffB);
        PG8_WAIT_V(6); PG8_BAR;
    }
    for (;;) {
        const bool has_next = S.next(ui + 1, nxt);
        const char* nA = has_next ? (const char*)g.A + (size_t)nxt.pm * tstep + (HALFM ? (size_t)nxt.hs * hstep : (size_t)0) : cA; const char* nB = has_next ? (const char*)g.Bt + (size_t)nxt.pn * tstep : cB;
        for (int t = 0; t < nt; t += 2) {
            const bool last = (t == nt - 2);
            const char* a1 = cA + (size_t)(t + 1) * kstep;
            const char* a2 = last ? nA : cA + (size_t)(t + 2) * kstep; const char* b2 = last ? nB : cB + (size_t)(t + 2) * kstep;
            const char* a3 = a2 + kstep; const char* b3 = b2 + kstep;
            if (last && has_next) S.a_ready(nxt);
            if constexpr (SP2) {
            PG8_LDB(B0, 0, 0); PG8_LDB(B1, 0, 1); PG8_SCHED; PG8_LDA(At, 0, 0); PG8_STAGE(PG8_SA(1, 1), a1 + hstepA, voffA);
            PG8_WAIT_V(8); PG8_WAIT_L(0); PG8_BAR; PG8_MMA(0, 0, At, B0); PG8_MMA(0, 1, At, B1); PG8_BAR; PG8_SCHED;
            if constexpr (!HALFM) PG8_LDA(At, 0, 1); PG8_STAGE(PG8_SB(0, 0), b2, voffB); PG8_STAGE(PG8_SB(0, 1), b2 + hstep, voffB); PG8_STAGE(PG8_SA(0, 0), a2, voffA);
            PG8_WAIT_V(8); PG8_WAIT_L(0); PG8_BAR; if constexpr (!HALFM) { PG8_MMA(1, 0, At, B0); PG8_MMA(1, 1, At, B1); } PG8_BAR; PG8_SCHED;
            PG8_LDB(B0, 1, 0); PG8_LDB(B1, 1, 1); PG8_SCHED; PG8_LDA(At, 1, 0); PG8_STAGE(PG8_SA(0, 1), a2 + hstepA, voffA);
            PG8_WAIT_V(8); PG8_WAIT_L(0); PG8_BAR; PG8_MMA(0, 0, At, B0); PG8_MMA(0, 1, At, B1); PG8_BAR; PG8_SCHED;
            if constexpr (!HALFM) PG8_LDA(At, 1, 1); PG8_STAGE(PG8_SB(1, 0), b3, voffB); PG8_STAGE(PG8_SB(1, 1), b3 + hstep, voffB); PG8_STAGE(PG8_SA(1, 0), a3, voffA);
            PG8_WAIT_V(8); PG8_WAIT_L(0); PG8_BAR; if constexpr (!HALFM) { PG8_MMA(1, 0, At, B0); PG8_MMA(1, 1, At, B1); } PG8_BAR; PG8_SCHED;
            } else {
            PG8_LDB(B0, 0, 0); PG8_SCHED; PG8_LDA(At, 0, 0); PG8_STAGE(PG8_SA(1, 1), a1 + hstep, voffA);
            PG8_WAIT_L(8); PG8_BAR; PG8_WAIT_L(0); PG8_MMA(0, 0, At, B0); PG8_BAR; PG8_SCHED;
            PG8_LDB(B1, 0, 1); PG8_STAGE(PG8_SB(0, 0), b2, voffB);
            PG8_BAR; PG8_WAIT_L(0); PG8_MMA(0, 1, At, B1); PG8_BAR;
            PG8_LDA(At, 0, 1); PG8_STAGE(PG8_SA(0, 0), a2, voffA);
            PG8_BAR; PG8_WAIT_L(0); PG8_MMA(1, 0, At, B0); PG8_BAR; PG8_SCHED;
            PG8_STAGE(PG8_SB(0, 1), b2 + hstep, voffB);
            PG8_WAIT_V(6); PG8_BAR; PG8_MMA(1, 1, At, B1); PG8_BAR;
            PG8_LDB(B0, 1, 0); PG8_SCHED; PG8_LDA(At, 1, 0); PG8_STAGE(PG8_SA(0, 1), a2 + hstep, voffA);
            PG8_WAIT_L(8); PG8_BAR; PG8_WAIT_L(0); PG8_MMA(0, 0, At, B0); PG8_BAR; PG8_SCHED;
            PG8_LDB(B1, 1, 1); PG8_STAGE(PG8_SB(1, 0), b3, voffB);
            PG8_BAR; PG8_WAIT_L(0); PG8_MMA(0, 1, At, B1); PG8_BAR;
            PG8_LDA(At, 1, 1); PG8_STAGE(PG8_SA(1, 0), a3, voffA);
            PG8_BAR; PG8_WAIT_L(0); PG8_MMA(1, 0, At, B0); PG8_BAR; PG8_SCHED;
            PG8_STAGE(PG8_SB(1, 1), b3 + hstep, voffB);
            PG8_WAIT_V(6); PG8_BAR; PG8_MMA(1, 1, At, B1); PG8_BAR;
            }
        }
        if constexpr (ALIGN_EPI) { if (wr == 0) PG8_BAR; }
        if constexpr (!Epi::AFTER_DRAIN) { E(acc, cur, wr, wc, fr, fq); S.done(cur); }
        if (!has_next) break;
#pragma unroll
        for (int a = 0; a < 2; ++a)
#pragma unroll
            for (int b = 0; b < 2; ++b)
#pragma unroll
                for (int m = 0; m < 4; ++m)
#pragma unroll
                    for (int n = 0; n < 2; ++n) acc[a][b][m][n] = (f32x4){0.f, 0.f, 0.f, 0.f};
        cur = nxt; cA = nA; cB = nB; ++ui;
        if constexpr (ALIGN_EPI) { if (wr == 1) PG8_BAR; }
    }
    PG8_WAIT_V(0);
    if constexpr (!ALIGN_EPI) { if (wr == 0) PG8_BAR; }
    PG8_BAR;
    if constexpr (Epi::AFTER_DRAIN) { E.fused(acc, cur, wr, wc, fr, fq, lds, wid, lane); S.done(cur); }
#undef PG8_SA
#undef PG8_SB
#undef PG8_STAGE
#undef PG8_LDA
#undef PG8_LDB
#undef PG8_MMA
#undef PG8_WAIT_V
#undef PG8_WAIT_L
#undef PG8_BAR
#undef PG8_SCHED
}
}
#define XB_TMO      128
#define XB_XCNT(j)  (256  + 64 * (j))
#define XB_XSUB(j)  (1280 + 64 * (j))
#define XB_XGEN(j)  (2304 + 64 * (j))
#define XB_TOP      3328
#define XB_TOPGEN   3392
#define XCD_BAR_WORDS 3456
#define XB_SPIN_CAP (1u << 18)
#define LAS __attribute__((address_space(3)))

__device__ __forceinline__ unsigned xb_ld(unsigned* p)              { return __hip_atomic_load(p, __ATOMIC_RELAXED, __HIP_MEMORY_SCOPE_AGENT); }
__device__ __forceinline__ unsigned xb_add(unsigned* p, unsigned v) { return __hip_atomic_fetch_add(p, v, __ATOMIC_RELAXED, __HIP_MEMORY_SCOPE_AGENT); }
__device__ __forceinline__ unsigned xb_xcc_id() { return (unsigned)__builtin_amdgcn_s_getreg((3 << 11) | 20) & 0xFu; }
#define XB_SPIN(cond, bar) do { unsigned _sp = 0; while (cond) { __builtin_amdgcn_s_sleep(1); \
    if ((++_sp & 255u) == 0u) { if (xb_ld(&(bar)[XB_TMO])) break; if (_sp > XB_SPIN_CAP) { atomicAdd(&(bar)[XB_TMO], 1u); break; } } } } while (0)

struct XcdBarrier {
    int wave0;
    unsigned* bar; unsigned x;
    volatile LAS unsigned* st;
};

__device__ __forceinline__ XcdBarrier xcd_barrier_post(unsigned* bar, volatile LAS unsigned* st) {
    XcdBarrier b; b.bar = bar; b.x = xb_xcc_id(); b.st = st;
    if (threadIdx.x == 0) (void)xb_add(&bar[XB_XCNT(b.x)], 1u);
    return b;
}
__device__ __forceinline__ void xcd_barrier_complete(unsigned* bar, unsigned x, unsigned& nloc, unsigned& nx) {
    const unsigned G = gridDim.x * gridDim.y * gridDim.z;
    unsigned sum, cnt, mine, sp = 0u;
    for (;;) {
        sum = 0u; cnt = 0u; mine = 0u;
#pragma unroll
        for (unsigned j = 0; j < 16; ++j) { const unsigned c = xb_ld(&bar[XB_XCNT(j)]); sum += c; cnt += (c > 0u) ? 1u : 0u; mine = (j == x) ? c : mine; }
        if (sum == G) break;
        __builtin_amdgcn_s_sleep(1);
        if ((++sp & 255u) == 0u) { if (xb_ld(&bar[XB_TMO])) break; if (sp > XB_SPIN_CAP) { atomicAdd(&bar[XB_TMO], 1u); break; } }
    }
    nloc = mine > 0u ? mine : 1u; nx = cnt > 0u ? cnt : 1u;
}

__device__ __forceinline__ void xcd_barrier(const XcdBarrier& b) {
    asm volatile("s_waitcnt vmcnt(0)" ::: "memory");
    __syncthreads();
    if (b.wave0 == 0 && fresh_lane() == 0) {
        unsigned* bar = b.bar;
        __builtin_amdgcn_s_waitcnt(0);
        unsigned nloc = b.st[0], nx = b.st[1];
        if (nloc == 0u) { xcd_barrier_complete(bar, b.x, nloc, nx); b.st[0] = nloc; b.st[1] = nx; }
        const unsigned old = xb_add(&bar[XB_XSUB(b.x)], 1u);
        const unsigned gen = old / nloc;
        if (old + 1u == (gen + 1u) * nloc) {
            __builtin_amdgcn_fence(__ATOMIC_RELEASE, "agent");
            asm volatile("s_waitcnt vmcnt(0)" ::: "memory");
            const unsigned og = xb_add(&bar[XB_TOP], 1u);
            const unsigned tg = og / nx;
            if (og + 1u == (tg + 1u) * nx) xb_add(&bar[XB_TOPGEN], 1u);
            else XB_SPIN(xb_ld(&bar[XB_TOPGEN]) == tg, bar);
            __builtin_amdgcn_fence(__ATOMIC_ACQUIRE, "agent");
            xb_add(&bar[XB_XGEN(b.x)], 1u);
            asm volatile("s_waitcnt vmcnt(0)" ::: "memory");
        } else {
            XB_SPIN(xb_ld(&bar[XB_XGEN(b.x)]) == gen, bar);
            __builtin_amdgcn_fence(__ATOMIC_ACQUIRE, "agent");
            asm volatile("s_waitcnt vmcnt(0)" ::: "memory");
        }
    }
    __syncthreads();
}

using pg8::bf16_t; using pg8::f32x4; using pg8::u32x4; using pg8::f32x2;
constexpr int SEQ = 4096, DM = 2048, INW = 8464;
constexpr float LOG2E = 1.4426950408889634f;
constexpr int NWAVES = 8;
constexpr int LDS_BYTES = 147456, MISC_OFF = LDS_BYTES - 256;
constexpr int N_PHASES = 12;

__constant__ float ROPE_INV[32] = {1.000000000e+00f, 7.498942614e-01f, 5.623413324e-01f, 4.216965139e-01f, 3.162277639e-01f, 2.371373773e-01f, 1.778279394e-01f, 1.333521307e-01f,
    1.000000015e-01f, 7.498941571e-02f, 5.623413250e-02f, 4.216965288e-02f, 3.162277490e-02f, 2.371373773e-02f, 1.778279431e-02f, 1.333521493e-02f,
    9.999999776e-03f, 7.498941850e-03f, 5.623413250e-03f, 4.216964822e-03f, 3.162277630e-03f, 2.371373586e-03f, 1.778279431e-03f, 1.333521446e-03f,
    1.000000047e-03f, 7.498942432e-04f, 5.623413017e-04f, 4.216965172e-04f, 3.162277571e-04f, 2.371373703e-04f, 1.778279402e-04f, 1.333521504e-04f};

struct Args { const float* in[18]; float* out; unsigned char* ws; int ph_lo, ph_hi; };
struct Frame {
    LAS unsigned char* lds; int wave, G, vcu;
    const Args* a; float* out; unsigned char* ws;
};
#define FIN(i) (F.a->in[i])
#define WSP(T, off) ((T*)(ws_l + (off)))
#define WS_LOCAL size_t wz_ = 0; int bid = (int)blockIdx.x, G_l = F.G; asm volatile("" : "+s"(wz_), "+s"(bid), "+s"(G_l)); unsigned char* const ws_l = F.ws + wz_; (void)bid; (void)G_l;
#define PHASE_LOCALS int lane_ = fresh_lane(); asm volatile("" : "+v"(lane_)); const int lane = lane_, wave = F.wave, tid = wave * 64 + lane; (void)tid; WS_LOCAL

__device__ __forceinline__ float bf_lo(unsigned w) { return __uint_as_float(w << 16); }
__device__ __forceinline__ float bf_hi(unsigned w) { return __uint_as_float(w & 0xffff0000u); }
__device__ __forceinline__ float wave_max(float v) { for (int o = 32; o; o >>= 1) v = fmaxf(v, __shfl_xor(v, o)); return v; }
__device__ __forceinline__ float wave_sum(float v) { for (int o = 32; o; o >>= 1) v += __shfl_xor(v, o); return v; }
#define LDS_WAVE_SYNC() asm volatile("s_waitcnt lgkmcnt(0)" ::: "memory")

__device__ __forceinline__ int t5_bucket(int n) {
    if (n < 16) return n;
    int b = 16;
    b += (n >= 22) + (n >= 30) + (n >= 40) + (n >= 54) + (n >= 73) + (n >= 99) + (n >= 134) + (n >= 182) + (n >= 246) + (n >= 332) + (n >= 450) + (n >= 609) + (n >= 825) + (n >= 1117) + (n >= 1513);
    return b;
}
__device__ __forceinline__ int src_in(int n) {
    if (n < 256) return 384 + n;
    if (n < 512) return n - 256;
    if (n < 640) return n - 256;
    if (n < 704) { const int t = n - 640; return 640 + ((t & 1) ? 32 + (t >> 1) : (t >> 1)); }
    if (n < 768) return 4800 + (n - 704);
    if (n < 784) return 4864 + (n - 768);
    if (n < 1024) return -1;
    if (n < 2048) return 3776 + (n - 1024);
    if (n < 3584) return 704 + (n - 2048);
    if (n < 5120) return 2240 + (n - 3584);
    if (n < 6656) return 4880 + (n - 5120);
    return 6416 + (n - 6656);
}
__device__ __forceinline__ int src_uq(int n) { const int h = n / 192, i = n % 192; if (i < 128) return n; const int t = i - 128; return h * 192 + 128 + ((t & 1) ? 32 + (t >> 1) : (t >> 1)); }

struct Src8 { int ia, ib, kind; };
__device__ __forceinline__ Src8 src8_of(int mat, int n0) {
    Src8 r; int c0 = n0; r.kind = 0;
    if (mat == 0) { if (n0 >= 640 && n0 < 704) { r.kind = 1; c0 = 640 + ((n0 - 640) >> 1); } else c0 = src_in(n0); }
    else if (mat == 2) { const int h = n0 / 192, i0 = n0 % 192; if (i0 >= 128) { r.kind = 1; c0 = h * 192 + 128 + ((i0 - 128) >> 1); } }
    if (c0 < 0) { r.kind = 2; c0 = 0; }
    r.ia = c0; r.ib = (r.kind == 1) ? c0 + 32 : c0 + 4;
    return r;
}
__device__ __forceinline__ void combine8(const Src8& s, const f32x4& a, const f32x4& b, float gk, float (&o)[8]) {
    if (s.kind == 1) { o[0] = a[0]; o[1] = b[0]; o[2] = a[1]; o[3] = b[1]; o[4] = a[2]; o[5] = b[2]; o[6] = a[3]; o[7] = b[3]; }
    else { o[0] = a[0]; o[1] = a[1]; o[2] = a[2]; o[3] = a[3]; o[4] = b[0]; o[5] = b[1]; o[6] = b[2]; o[7] = b[3]; }
#pragma unroll
    for (int e = 0; e < 8; ++e) o[e] = (s.kind == 2) ? 0.f : o[e] * gk;
}
struct WTile { int mat, nt, kt, K, ldsrc; const float* src; bf16_t* dst; const float* gain; };
__device__ __forceinline__ WTile wtile_of(const Frame& F, unsigned char* ws_l, int l, int v) {
    constexpr int U_IN = 136 * 32, U_OUT = 32 * 32, U_UQ = 12 * 6;
    WTile t; t.gain = nullptr;
    if (v < U_IN) { t.mat = 0; t.nt = v % 136; t.kt = v / 136; t.K = 2048; t.ldsrc = INW; t.src = FIN(6) + (size_t)l * 2048 * INW; t.dst = WSP(bf16_t, l == 0 ? WS_WTIN0 : WS_WTIN1); }
    else if ((v -= U_IN) < U_OUT) { t.mat = 1; t.nt = v & 31; t.kt = v >> 5; t.K = 2048; t.ldsrc = 2048; t.src = FIN(16) + (size_t)l * 2048 * 2048; t.dst = WSP(bf16_t, WS_WTOUT) + (size_t)l * 2048 * 2048; }
    else if ((v -= U_OUT) < U_UQ) { t.mat = 2; t.nt = v % 12; t.kt = v / 12; t.K = 384; t.ldsrc = 768; t.src = FIN(8) + (size_t)l * 384 * 768; t.dst = WSP(bf16_t, WS_WTUQ) + (size_t)l * 768 * 384; t.gain = FIN(7) + l * 384; }
    else { v -= U_UQ; t.mat = 3; t.nt = v & 15; t.kt = v >> 4; t.K = 256; t.ldsrc = 1024; t.src = FIN(10) + (size_t)l * 256 * 1024; t.dst = WSP(bf16_t, WS_WTUKV) + (size_t)l * 1024 * 256; t.gain = FIN(9) + l * 256; }
    return t;
}
__device__ __forceinline__ void convert_weights(const Frame& F, int l, int qidx) {
    PHASE_LOCALS
    LAS float* tiles = (LAS float*)F.lds;
    constexpr int U_L = 136 * 32 + 32 * 32 + 12 * 6 + 16 * 4, NB = 4, TSZ = 64 * 65;
    unsigned* qctr = (unsigned*)(ws_l + WS_CTL + 16384 + qidx * 256);
    volatile LAS unsigned* qslot = (volatile LAS unsigned*)(F.lds + MISC_OFF) + 16;
    if (tid == 0) { const unsigned q0_ = atomicAdd(qctr, (unsigned)NB), q1_ = atomicAdd(qctr, (unsigned)NB); qslot[0] = q0_; qslot[1] = q1_; }
    __syncthreads();
    int u0 = (int)qslot[0], u1 = (int)qslot[1];
    __syncthreads();
    const int k = tid >> 3, n8 = (tid & 7) * 8;
    WTile t[NB]; Src8 sd[NB]; f32x4 va[NB], vb[NB]; float gk[NB];
#define CW_LOAD(U) do { _Pragma("unroll") for (int i = 0; i < NB; ++i) { t[i] = wtile_of(F, ws_l, l, (U) + i); sd[i] = src8_of(t[i].mat, t[i].nt * 64 + n8); } \
        _Pragma("unroll") for (int i = 0; i < NB; ++i) { const float* srow = t[i].src + (size_t)(t[i].kt * 64 + k) * t[i].ldsrc; \
            va[i] = *(const f32x4*)(srow + sd[i].ia); vb[i] = *(const f32x4*)(srow + sd[i].ib); gk[i] = t[i].gain ? t[i].gain[t[i].kt * 64 + k] : 1.0f; } } while (0)
    if (u0 < U_L) CW_LOAD(u0);
    while (u0 < U_L) {
        unsigned u2 = 0u; if (tid == 0) u2 = atomicAdd(qctr, (unsigned)NB);
#pragma unroll
        for (int i = 0; i < NB; ++i) { float o[8]; combine8(sd[i], va[i], vb[i], gk[i], o);
#pragma unroll
            for (int e = 0; e < 8; ++e) tiles[i * TSZ + k * 65 + n8 + e] = o[e]; }
        bf16_t* dst[NB]; int dK[NB];
#pragma unroll
        for (int i = 0; i < NB; ++i) { dK[i] = t[i].K; dst[i] = t[i].dst + (size_t)(t[i].nt * 64) * t[i].K + t[i].kt * 64; }
        if (u1 < U_L) CW_LOAD(u1);
        __syncthreads();
        const int n = tid >> 3, k8 = (tid & 7) * 8;
#pragma unroll
        for (int i = 0; i < NB; ++i) {
            float v[8];
#pragma unroll
            for (int e = 0; e < 8; ++e) v[e] = tiles[i * TSZ + (k8 + e) * 65 + n];
            u32x4 w; w.x = pg8::cvt_pk_bf16(v[0], v[1]); w.y = pg8::cvt_pk_bf16(v[2], v[3]); w.z = pg8::cvt_pk_bf16(v[4], v[5]); w.w = pg8::cvt_pk_bf16(v[6], v[7]);
            *(u32x4*)(dst[i] + (size_t)n * dK[i] + k8) = w;
        }
        if (tid == 0) qslot[0] = u2;
        __syncthreads();
        u0 = u1; u1 = (int)qslot[0];
    }
#undef CW_LOAD
    __syncthreads();
}
__device__ __forceinline__ void p0_prologue(const Frame& F) {
    PHASE_LOCALS
    LAS float* tile = (LAS float*)F.lds;
    for (int it = bid; it < 192; it += G_l) {
        const int l = it / 96, n0 = (it % 96) * 64;
        LAS float* sc = tile;
        LAS float* part = tile + 8192;
        for (int i = tid; i < 8192; i += NWAVES * 64) sc[i] = pg8::silu_f(FIN(1)[i]);
        __syncthreads();
        const int kk = tid >> 4, c4 = (tid & 15) * 4;
        float acc[4][4];
#pragma unroll
        for (int i = 0; i < 4; ++i)
#pragma unroll
            for (int b = 0; b < 4; ++b) acc[i][b] = 0.f;
        const float* wp = FIN(2) + (size_t)l * 2048 * 6144 + n0 + c4;
#pragma unroll 8
        for (int k = kk; k < 2048; k += 32) {
            const f32x4 w = *(const f32x4*)(wp + (size_t)k * 6144);
#pragma unroll
            for (int b = 0; b < 4; ++b) { const float sv = sc[b * 2048 + k]; acc[0][b] += sv * w[0]; acc[1][b] += sv * w[1]; acc[2][b] += sv * w[2]; acc[3][b] += sv * w[3]; }
        }
#pragma unroll
        for (int i = 0; i < 4; ++i) *(LAS f32x4*)(part + (kk * 64 + c4 + i) * 4) = (f32x4){acc[i][0], acc[i][1], acc[i][2], acc[i][3]};
        __syncthreads();
        if (tid < 256) {
            const int n = tid >> 2, b = tid & 3;
            float sum = 0.f;
            for (int q = 0; q < 32; ++q) sum += part[(q * 64 + n) * 4 + b];
            WSP(float, WS_MOD)[(size_t)(l * 4 + b) * 6144 + n0 + n] = sum + FIN(3)[l * 6144 + n0 + n];
        }
        __syncthreads();
    }
    convert_weights(F, 0, 16);
    convert_weights(F, 1, 17);
    const int gt = bid * (NWAVES * 64) + tid, GT = G_l * NWAVES * 64;
    for (int i = gt; i < 4096 * 32; i += GT) {
        const int pos = i >> 5, f = i & 31;
        const float ang = (float)pos * ROPE_INV[f];
        const double x = (double)ang;
        const double q = __builtin_rint(x * 0.63661977236758134308);
        double r = __builtin_fma(-q, 1.57079632679489655800e+00, x); r = __builtin_fma(-q, 6.12323399573676603587e-17, r);
        const double r2 = r * r;
        const double sn = r * (1.0 + r2 * (-1.0 / 6 + r2 * (1.0 / 120 + r2 * (-1.0 / 5040 + r2 * (1.0 / 362880 + r2 * (-1.0 / 39916800 + r2 * (1.0 / 6227020800.0)))))));
        const double cn = 1.0 + r2 * (-0.5 + r2 * (1.0 / 24 + r2 * (-1.0 / 720 + r2 * (1.0 / 40320 + r2 * (-1.0 / 3628800 + r2 * (1.0 / 479001600.0))))));
        const int qi = (int)q & 3;
        const double s = (qi == 0) ? sn : (qi == 1) ? cn : (qi == 2) ? -sn : -cn;
        const double c = (qi == 0) ? cn : (qi == 1) ? -sn : (qi == 2) ? -cn : sn;
        f32x2 o; o.x = (float)c; o.y = (float)s; WSP(f32x2, WS_ROPE)[i] = o;
    }
    for (int i = gt; i < 8 * 4096; i += GT) { const int hh = i >> 12, d = i & 4095; WSP(float, WS_TCD)[i] = FIN(17)[t5_bucket(d) * 12 + 4 + hh] * LOG2E; }
    for (int i = gt; i < 3 * 4 * 192; i += GT) {
        const int g = i / 768, h = (i / 192) & 3, j = i % 192;
        const int dist = (g == 0 ? 1 : g == 1 ? 4 : 16) * (j > 128 ? 128 : j);
        WSP(float, WS_TB)[i] = FIN(17)[t5_bucket(dist) * 12 + h] * LOG2E;
    }
    if (gt < 2) {
        const int l = gt; float s1 = 0.f, s2 = 0.f;
        for (int i = 0; i < 64; ++i) { s1 += FIN(11)[l * 64 + i] * FIN(12)[l * 64 + i]; s2 += FIN(13)[l * 64 + i] * FIN(14)[l * 64 + i]; }
        const float li = (l == 0) ? 0.2f : 0.35550906759096926f;
        WSP(float, WS_CONST)[l] = expf(s1) - expf(s2) + li;
    }
}

#define DPP_ADD(v, ctrl) v += __builtin_bit_cast(float, __builtin_amdgcn_update_dpp(0, __builtin_bit_cast(int, v), ctrl, 0xF, 0xF, true))
__device__ __forceinline__ float wave_sum_v(float v) {
    DPP_ADD(v, 0xB1); DPP_ADD(v, 0x4E); DPP_ADD(v, 0x141); DPP_ADD(v, 0x140);
    { auto r = __builtin_amdgcn_permlane16_swap(__float_as_uint(v), __float_as_uint(v), false, false); v = __uint_as_float(r[0]) + __uint_as_float(r[1]); }
    { auto r = __builtin_amdgcn_permlane32_swap(__float_as_uint(v), __float_as_uint(v), false, false); v = __uint_as_float(r[0]) + __uint_as_float(r[1]); }
    return v;
}
constexpr int NV_A = 0, NV_B = 2048, NV_C = 4096;
__device__ __forceinline__ void lds8(const LAS float* p, float (&o)[8]) { const f32x4 a = *(const LAS f32x4*)p, b = *(const LAS f32x4*)(p + 4); o[0] = a[0]; o[1] = a[1]; o[2] = a[2]; o[3] = a[3]; o[4] = b[0]; o[5] = b[1]; o[6] = b[2]; o[7] = b[3]; }
__device__ __forceinline__ void store_h8(bf16_t* hp, const float (&v)[8], float rs, const LAS float* vb, const LAS float* vc) {
    float B[8], C[8]; lds8(vb, B); lds8(vc, C);
    float h[8];
#pragma unroll
    for (int e = 0; e < 8; ++e) h[e] = v[e] * rs * B[e] + C[e];
    u32x4 w; w.x = pg8::cvt_pk_bf16(h[0], h[1]); w.y = pg8::cvt_pk_bf16(h[2], h[3]); w.z = pg8::cvt_pk_bf16(h[4], h[5]); w.w = pg8::cvt_pk_bf16(h[6], h[7]);
    *(u32x4*)hp = w;
}
__device__ __forceinline__ void p_pre0(const Frame& F) {
    PHASE_LOCALS
    LAS float* vec = (LAS float*)F.lds;
    const float* mod = WSP(float, WS_MOD);
    for (int t = bid; t < M / 64; t += G_l) {
        const int b = t >> 6;
        __syncthreads();
        { const float* mb = mod + (size_t)(0 * 4 + b) * 6144; const float* gp = FIN(4);
          for (int c = tid; c < 2048; c += NWAVES * 64) { vec[NV_B + c] = gp[c] * (1.0f + mb[2048 + c]); vec[NV_C + c] = mb[c]; } }
        __syncthreads();
#pragma unroll 1
        for (int rp = 0; rp < 8; ++rp) {
            const int r0 = t * 64 + wave * 8 + rp;
            float xv[1][4][8];
#pragma unroll
            for (int q = 0; q < 1; ++q)
#pragma unroll
                for (int i = 0; i < 4; ++i) { const float* xp = FIN(0) + (size_t)(r0 + q) * DM + (i * 64 + lane) * 8; const f32x4 a = *(const f32x4*)xp, c = *(const f32x4*)(xp + 4);
                    xv[q][i][0] = a[0]; xv[q][i][1] = a[1]; xv[q][i][2] = a[2]; xv[q][i][3] = a[3]; xv[q][i][4] = c[0]; xv[q][i][5] = c[1]; xv[q][i][6] = c[2]; xv[q][i][7] = c[3]; }
#pragma unroll
            for (int q = 0; q < 1; ++q) {
                float ss = 0.f;
#pragma unroll
                for (int i = 0; i < 4; ++i)
#pragma unroll
                    for (int e = 0; e < 8; ++e) ss += xv[q][i][e] * xv[q][i][e];
                ss = wave_sum_v(ss);
                const float rs = __builtin_amdgcn_rsqf(ss * (1.0f / 2048.0f) + 1e-6f);
#pragma unroll
                for (int i = 0; i < 4; ++i) { const int c = (i * 64 + lane) * 8; store_h8(WSP(bf16_t, WS_H) + (size_t)(r0 + q) * DM + c, xv[q][i], rs, vec + NV_B + c, vec + NV_C + c); }
            }
        }
    }
    __syncthreads();
}
__device__ __forceinline__ void p_post(const Frame& F, int l) {
    PHASE_LOCALS
    LAS float* vec = (LAS float*)F.lds;
    const float* mod = WSP(float, WS_MOD);
    const bf16_t* Y = WSP(bf16_t, WS_Y);
    const float* xin = (l == 0) ? FIN(0) : F.out;
    for (int t = bid; t < M / 64; t += G_l) {
        const int b = t >> 6;
        __syncthreads();
        { const float* gate = mod + (size_t)(l * 4 + b) * 6144 + 4096; const float* gpo = FIN(5) + l * DM; const float* mb1 = mod + (size_t)(1 * 4 + b) * 6144; const float* gp1 = FIN(4) + DM;
          for (int c = tid; c < 2048; c += NWAVES * 64) { vec[NV_A + c] = gate[c] * gpo[c]; if (l == 0) { vec[NV_B + c] = gp1[c] * (1.0f + mb1[2048 + c]); vec[NV_C + c] = mb1[c]; } } }
        __syncthreads();
#pragma unroll 1
        for (int rp = 0; rp < 8; ++rp) {
            const int r0 = t * 64 + wave * 8 + rp;
            u32x4 yr[1][4]; float xv[1][4][8];
#pragma unroll
            for (int q = 0; q < 1; ++q)
#pragma unroll
                for (int i = 0; i < 4; ++i) { const size_t o = (size_t)(r0 + q) * DM + (i * 64 + lane) * 8; yr[q][i] = *(const u32x4*)(Y + o);
                    if (l == 0) { const f32x4 a = *(const f32x4*)(xin + o), c = *(const f32x4*)(xin + o + 4);
                        xv[q][i][0] = a[0]; xv[q][i][1] = a[1]; xv[q][i][2] = a[2]; xv[q][i][3] = a[3]; xv[q][i][4] = c[0]; xv[q][i][5] = c[1]; xv[q][i][6] = c[2]; xv[q][i][7] = c[3]; }
                    else {
                        const u32x4 w = *(const u32x4*)((const bf16_t*)(xin + (size_t)(r0 + q) * DM) + (i * 64 + lane) * 8);
                        xv[q][i][0] = bf_lo(w.x); xv[q][i][1] = bf_hi(w.x); xv[q][i][2] = bf_lo(w.y); xv[q][i][3] = bf_hi(w.y); xv[q][i][4] = bf_lo(w.z); xv[q][i][5] = bf_hi(w.z); xv[q][i][6] = bf_lo(w.w); xv[q][i][7] = bf_hi(w.w); } }
#pragma unroll
            for (int q = 0; q < 1; ++q) {
                float yv[4][8]; float ss = 0.f;
#pragma unroll
                for (int i = 0; i < 4; ++i) { const u32x4 w = yr[q][i];
                    yv[i][0] = bf_lo(w.x); yv[i][1] = bf_hi(w.x); yv[i][2] = bf_lo(w.y); yv[i][3] = bf_hi(w.y); yv[i][4] = bf_lo(w.z); yv[i][5] = bf_hi(w.z); yv[i][6] = bf_lo(w.w); yv[i][7] = bf_hi(w.w);
#pragma unroll
                    for (int e = 0; e < 8; ++e) ss += yv[i][e] * yv[i][e]; }
                ss = wave_sum_v(ss);
                const float rs = __builtin_amdgcn_rsqf(ss * (1.0f / 2048.0f) + 1e-6f);
                float ss2 = 0.f;
#pragma unroll
                for (int i = 0; i < 4; ++i) { const int c = (i * 64 + lane) * 8; float A[8]; lds8(vec + NV_A + c, A);
#pragma unroll
                    for (int e = 0; e < 8; ++e) { const float xn = xv[q][i][e] + A[e] * (yv[i][e] * rs); xv[q][i][e] = xn; ss2 += xn * xn; }
                    float* op = F.out + (size_t)(r0 + q) * DM + c;
                    if (l == 0) { u32x4 w; w.x = pg8::cvt_pk_bf16(xv[q][i][0], xv[q][i][1]); w.y = pg8::cvt_pk_bf16(xv[q][i][2], xv[q][i][3]); w.z = pg8::cvt_pk_bf16(xv[q][i][4], xv[q][i][5]); w.w = pg8::cvt_pk_bf16(xv[q][i][6], xv[q][i][7]);
                        *(u32x4*)((bf16_t*)(F.out + (size_t)(r0 + q) * DM) + c) = w; }
                    else { *(f32x4*)op = (f32x4){xv[q][i][0], xv[q][i][1], xv[q][i][2], xv[q][i][3]}; *(f32x4*)(op + 4) = (f32x4){xv[q][i][4], xv[q][i][5], xv[q][i][6], xv[q][i][7]}; } }
                if (l == 0) {
                    ss2 = wave_sum_v(ss2);
                    const float rs2 = __builtin_amdgcn_rsqf(ss2 * (1.0f / 2048.0f) + 1e-6f);
#pragma unroll
                    for (int i = 0; i < 4; ++i) { const int c = (i * 64 + lane) * 8; store_h8(WSP(bf16_t, WS_H) + (size_t)(r0 + q) * DM + c, xv[q][i], rs2, vec + NV_B + c, vec + NV_C + c); }
                }
            }
        }
    }
    __syncthreads();
}

__device__ __forceinline__ void p_gemm1(const Frame& F, int l) {
    WS_LOCAL
    pg8::Gemm g; g.A = WSP(bf16_t, WS_H); g.Bt = WSP(bf16_t, l == 0 ? WS_WTIN0 : WS_WTIN1); g.M = M; g.N = NW1; g.K = 2048;
    const bool full_grid = (G_l == 256);
    pg8::StaticOrder S; S.init(M, full_grid ? 32 * 256 : NW1, G_l, bid);
    pg8::EpiIn E; E.ws = ws_l;
    pg8::gemm_phase<pg8::EpiIn, pg8::StaticOrder, true, true>(F.lds, g, S, E, F.wave);
    if (full_grid) {
        pg8::TailOrder T; T.c = bid;
        pg8::EpiTail ET; ET.ws = ws_l;
        pg8::gemm_phase<pg8::EpiTail, pg8::TailOrder, true, true, true>(F.lds, g, T, ET, F.wave);
    }

}
__device__ __forceinline__ void p_upq(const Frame& F, int l) {
    WS_LOCAL
    pg8::Gemm g; g.A = WSP(bf16_t, WS_CQ); g.Bt = WSP(bf16_t, WS_WTUQ) + (size_t)l * 768 * 384; g.M = M; g.N = 768; g.K = 384;
    pg8::StaticOrder S; S.init(M, 768, G_l, bid);
    pg8::EpiQ E; E.ws = ws_l;
    pg8::gemm_phase<pg8::EpiQ, pg8::StaticOrder, true, true>(F.lds, g, S, E, F.wave);
}
__device__ __forceinline__ void p_upkv(const Frame& F, int l) {
    WS_LOCAL
    pg8::Gemm g; g.A = WSP(bf16_t, WS_CKV); g.Bt = WSP(bf16_t, WS_WTUKV) + (size_t)l * 1024 * 256; g.M = M; g.N = 1024; g.K = 256;
    pg8::StaticOrder S; S.init(M, 1024, G_l, bid);
    pg8::EpiKV E; E.ws = ws_l;
    pg8::gemm_phase<pg8::EpiKV, pg8::StaticOrder, true, true>(F.lds, g, S, E, F.wave);
}
__device__ __forceinline__ void p_gemm2(const Frame& F, int l) {
    WS_LOCAL
    pg8::Gemm g; g.A = WSP(bf16_t, WS_MIXED); g.Bt = WSP(bf16_t, WS_WTOUT) + (size_t)l * 2048 * 2048; g.M = M; g.N = 2048; g.K = 2048;
    pg8::StaticOrder S; S.init(M, 2048, G_l, bid);
    pg8::EpiY E; E.ws = ws_l;
    pg8::gemm_phase<pg8::EpiY, pg8::StaticOrder, true, true>(F.lds, g, S, E, F.wave);
}

__device__ __forceinline__ unsigned score_key(float x) { const unsigned b = __float_as_uint(x); return b ^ ((unsigned)((int)b >> 31) | 0x80000000u); }
__device__ __forceinline__ int wave_sum_i(int v) { for (int o = 32; o; o >>= 1) v += __shfl_xor(v, o); return v; }
extern "C" __device__ int llvm_writelane_i32(int, int, int) __asm("llvm.amdgcn.writelane.i32");
__device__ __forceinline__ unsigned wave_max_u(unsigned v) {
#define DPP_MAXU(v, ctrl) v = max(v, (unsigned)__builtin_amdgcn_update_dpp(0, (int)v, ctrl, 0xF, 0xF, true))
    DPP_MAXU(v, 0xB1); DPP_MAXU(v, 0x4E); DPP_MAXU(v, 0x141); DPP_MAXU(v, 0x140);
#undef DPP_MAXU
    const unsigned a = (unsigned)__builtin_amdgcn_readlane((int)v, 0), b = (unsigned)__builtin_amdgcn_readlane((int)v, 16), c = (unsigned)__builtin_amdgcn_readlane((int)v, 32), d = (unsigned)__builtin_amdgcn_readlane((int)v, 48);
    return max(max(a, b), max(c, d));
}
__device__ __forceinline__ bool select_row(const unsigned (&u)[64], int qpos, unsigned long long* mrow, int lane, LAS unsigned* cbuf  ) {
    unsigned long long myw = 0ull;
    if (qpos < 256) {
        const int lo = lane * 64;
        if (lo + 63 <= qpos) myw = ~0ull; else if (lo <= qpos) myw = (~0ull) >> (63 - (qpos - lo)); else myw = 0ull;
        mrow[lane] = myw; return true;
    }
    const int nj = (qpos >> 6) + 1;
    unsigned thr = 0u; bool exact = false;
    int lo_cnt = qpos + 1, hi_cnt = 0, bit = 31, scan = 6;
    unsigned P;
    {
        unsigned mx = 0u;
#pragma unroll
        for (int g = 0; g < 8; ++g) {
            if (8 * g < nj) {
#pragma unroll
                for (int q = 0; q < 8; ++q) mx = max(mx, u[8 * g + q]);
            }
        }
        P = wave_max_u(mx) >> 23;
    }
#pragma unroll 1
    for (;;) {
        if (scan == 0) { if (bit < 0 || lo_cnt - hi_cnt <= 64) break; }
        const unsigned cand = scan ? (P << 23) : (thr | (1u << bit));
        int cnt = 0;
#pragma unroll
        for (int g = 0; g < 8; ++g) {
            if (8 * g < nj) {
                unsigned long long m8[8];
#pragma unroll
                for (int q = 0; q < 8; ++q) m8[q] = __ballot(u[8 * g + q] >= cand);
                asm volatile("" :: "s"(m8[0]), "s"(m8[1]), "s"(m8[2]), "s"(m8[3]), "s"(m8[4]), "s"(m8[5]), "s"(m8[6]), "s"(m8[7]));
#pragma unroll
                for (int q = 0; q < 8; ++q) cnt += __popcll(m8[q]);
            }
        }
        if (scan) {
            if (cnt >= 256) { thr = cand; lo_cnt = cnt; bit = 22; scan = 0; if (cnt == 256) { exact = true; break; } }
            else { hi_cnt = cnt; --P; if (--scan == 0) { hi_cnt = 0; bit = 31; } }
        } else {
            if (cnt >= 256) { thr = cand; lo_cnt = cnt; if (cnt == 256) { exact = true; break; } } else hi_cnt = cnt;
            --bit;
        }
    }
    if (!exact && bit >= 0) {
        const unsigned tlo = thr ? thr : 1u;
        const unsigned span = ((bit == 31) ? 0xFFFFFFFFu : (thr + ((2u << bit) - 1u))) - tlo;
        unsigned base = 0u;
        cbuf[lane] = 0u;
#pragma unroll
        for (int g = 0; g < 8; ++g) {
            if (8 * g < nj) {
#pragma unroll
                for (int j = 8 * g; j < 8 * g + 8; ++j) {
                    const bool inb = (u[j] - tlo) <= span;
                    const unsigned long long m = __ballot(inb);
                    if (inb) cbuf[__builtin_amdgcn_mbcnt_hi((unsigned)(m >> 32), __builtin_amdgcn_mbcnt_lo((unsigned)m, base))] = u[j];
                    base += (unsigned)__popcll(m);
                }
            }
        }
        asm volatile("s_waitcnt lgkmcnt(0)" ::: "memory");
        const unsigned uc = cbuf[lane];
#pragma unroll 1
        for (; bit >= 0; --bit) {
            const unsigned cand = thr | (1u << bit);
            const int cnt = hi_cnt + __popcll(__ballot(uc >= cand));
            if (cnt >= 256) { thr = cand; if (cnt == 256) { exact = true; break; } }
        }
    }
    if (thr == 0u) return false;
    int wlo = 0, whi = 0;
    if (exact) {
#pragma unroll
        for (int g = 0; g < 8; ++g) {
            if (8 * g < nj) {
#pragma unroll
                for (int j = 8 * g; j < 8 * g + 8; ++j) { const unsigned long long m = __ballot(u[j] >= thr); wlo = llvm_writelane_i32((int)(unsigned)m, j, wlo); whi = llvm_writelane_i32((int)(unsigned)(m >> 32), j, whi); }
            }
        }
    } else {
        int cgt = 0;
#pragma unroll
        for (int j = 0; j < 64; ++j) cgt += __popcll(__ballot(u[j] > thr));
        int need = 256 - cgt;
#pragma unroll
        for (int j = 0; j < 64; ++j) {
            const unsigned long long gtm = __ballot(u[j] > thr); unsigned long long eqm = __ballot(u[j] == thr);
            int pc = __popcll(eqm);
            while (pc > need) { eqm &= ~(1ull << (63 - __clzll((long long)eqm))); --pc; }
            need -= pc;
            const unsigned long long m = gtm | eqm;
            wlo = llvm_writelane_i32((int)(unsigned)m, j, wlo); whi = llvm_writelane_i32((int)(unsigned)(m >> 32), j, whi);
        }
    }
    mrow[lane] = ((unsigned long long)(unsigned)whi << 32) | (unsigned long long)(unsigned)wlo;
    return true;
}
namespace fa {
typedef short bf16x8 __attribute__((ext_vector_type(8)));
typedef short s16x4 __attribute__((ext_vector_type(4)));
typedef float f32x16 __attribute__((ext_vector_type(16)));
constexpr int SHM_K = 16384, SHM_V = 16384, SHM_KR = 8192;
constexpr int NVB = 3;
constexpr int L_V = 0, L_K = NVB * SHM_V, L_KR = L_K + 2 * SHM_K, L_WS = L_KR + 2 * SHM_KR, L_TAB = L_WS + 8 * 256, TAB_N = 4416, L_END = L_TAB + TAB_N * 4;
static_assert(L_END <= 131072, "attention LDS map");
#define FA_KSWZ(row, colB) ((row) * 256 + ((colB) ^ (((row) & 7) << 4)))
#define FA_KRSWZ(row, colB) ((row) * 128 + ((colB) ^ (((row) & 7) << 4)))
#define FA_SBAR() __builtin_amdgcn_sched_barrier(0)
__device__ __forceinline__ int v_st(int k, int c) { const int kk = (k & ~0xC) | ((k & 4) << 1) | ((k & 8) >> 1); return ((kk >> 3) * 4 + (c >> 5)) * 512 + ((kk & 7) * 32 + (c & 31)) * 2; }
__device__ __forceinline__ int v_rd_base(int lane) { return ((lane & 3) << 3) | (((lane >> 2) & 3) << 6) | (((lane >> 4) & 1) << 5) | (((lane >> 5) & 1) << 8); }
constexpr int v_rd_off(int d0, int ks, int half) { return d0 * 512 + ks * 4096 + half * 2048; }
__device__ __forceinline__ int crow(int r, int hi) { return (r & 3) + 8 * (r >> 2) + 4 * hi; }
__device__ __forceinline__ unsigned cvtpk(float lo, float hi) { unsigned r; asm("v_cvt_pk_bf16_f32 %0, %1, %2" : "=v"(r) : "v"(lo), "v"(hi)); return r; }

#define FA_KRD(dst, addr, off) asm volatile("ds_read_b128 %0, %1 offset:%2" : "=&v"(dst) : "v"(addr), "i"(off) : "memory")
#define FA_LWAIT(n) do { asm volatile("s_waitcnt lgkmcnt(" #n ")" ::: "memory"); FA_SBAR(); } while (0)
template <int D0, int ND>
__device__ __forceinline__ void qkt_main(f32x16& p0, f32x16& p1, const LAS char* Kt, int r32, int hi, const bf16x8* qr) {
    unsigned kb[4];
#pragma unroll
    for (int dd = 0; dd < 4; ++dd) kb[dd] = (unsigned)(size_t)Kt + FA_KSWZ(r32, (dd * 16 + hi * 8) * 2);
    bf16x8 a0[2], a1[2];
#define FA_QRD(i) do { constexpr int d0_ = D0 + (i); FA_KRD(a0[(i) & 1], kb[d0_ & 3], (d0_ >> 2) * 128); FA_KRD(a1[(i) & 1], kb[d0_ & 3], (d0_ >> 2) * 128 + 32 * 256); } while (0)
#define FA_QMM(i) do { p0 = __builtin_amdgcn_mfma_f32_32x32x16_bf16(a0[(i) & 1], qr[i], p0, 0, 0, 0); p1 = __builtin_amdgcn_mfma_f32_32x32x16_bf16(a1[(i) & 1], qr[i], p1, 0, 0, 0); FA_SBAR(); } while (0)
    FA_QRD(0); FA_QRD(1);
    FA_LWAIT(2); FA_QMM(0); FA_QRD(2);
    FA_LWAIT(2); FA_QMM(1); FA_QRD(3);
    if constexpr (ND == 4) { FA_LWAIT(2); FA_QMM(2); FA_LWAIT(0); FA_QMM(3); }
    else {
        FA_LWAIT(2); FA_QMM(2); FA_QRD(4);
        FA_LWAIT(2); FA_QMM(3); FA_QRD(5);
        FA_LWAIT(2); FA_QMM(4); FA_QRD(6);
        FA_LWAIT(2); FA_QMM(5); FA_QRD(7);
        FA_LWAIT(2); FA_QMM(6); FA_LWAIT(0); FA_QMM(7);
    }
#undef FA_QMM
#undef FA_QRD
}
__device__ __forceinline__ void qkt_rope(f32x16& p0, f32x16& p1, const LAS char* Kt, int r32, int hi, const bf16x8* qr) {
    unsigned kb[4];
#pragma unroll
    for (int i = 0; i < 4; ++i) kb[i] = (unsigned)(size_t)Kt + FA_KRSWZ(r32, (i * 16 + hi * 8) * 2);
    bf16x8 a0[2], a1[2];
#define FA_QRD(i) do { FA_KRD(a0[(i) & 1], kb[i], 0); FA_KRD(a1[(i) & 1], kb[i], 32 * 128); } while (0)
#define FA_QMM(i) do { p0 = __builtin_amdgcn_mfma_f32_32x32x16_bf16(a0[(i) & 1], qr[i], p0, 0, 0, 0); p1 = __builtin_amdgcn_mfma_f32_32x32x16_bf16(a1[(i) & 1], qr[i], p1, 0, 0, 0); FA_SBAR(); } while (0)
    FA_QRD(0); FA_QRD(1);
    FA_LWAIT(2); FA_QMM(0); FA_QRD(2);
    FA_LWAIT(2); FA_QMM(1); FA_QRD(3);
    FA_LWAIT(2); FA_QMM(2); FA_LWAIT(0); FA_QMM(3);
#undef FA_QMM
#undef FA_QRD
}
__device__ __forceinline__ void pv_tile(f32x16* o, int vb0  , bf16x8 pa0, bf16x8 pa1, bf16x8 pa2, bf16x8 pa3) {
#define FA_TRRD(dst, off) asm volatile("ds_read_b64_tr_b16 %0, %1 offset:%2" : "=&v"(dst) : "v"(vb0), "i"(off) : "memory")
#define FA_RD8(S, ks) do { constexpr int b_ = v_rd_off(0, ks, 0); \
        FA_TRRD(S##l0, b_); FA_TRRD(S##h0, b_ + 2048); FA_TRRD(S##l1, b_ + 512); FA_TRRD(S##h1, b_ + 512 + 2048); FA_TRRD(S##l2, b_ + 1024); FA_TRRD(S##h2, b_ + 1024 + 2048); FA_TRRD(S##l3, b_ + 1536); FA_TRRD(S##h3, b_ + 1536 + 2048); } while (0)
#define FA_MM4(S, pa) do { \
        o[0] = __builtin_amdgcn_mfma_f32_32x32x16_bf16(pa, (bf16x8){S##l0[0], S##l0[1], S##l0[2], S##l0[3], S##h0[0], S##h0[1], S##h0[2], S##h0[3]}, o[0], 0, 0, 0);   \
        o[1] = __builtin_amdgcn_mfma_f32_32x32x16_bf16(pa, (bf16x8){S##l1[0], S##l1[1], S##l1[2], S##l1[3], S##h1[0], S##h1[1], S##h1[2], S##h1[3]}, o[1], 0, 0, 0);   \
        o[2] = __builtin_amdgcn_mfma_f32_32x32x16_bf16(pa, (bf16x8){S##l2[0], S##l2[1], S##l2[2], S##l2[3], S##h2[0], S##h2[1], S##h2[2], S##h2[3]}, o[2], 0, 0, 0);   \
        o[3] = __builtin_amdgcn_mfma_f32_32x32x16_bf16(pa, (bf16x8){S##l3[0], S##l3[1], S##l3[2], S##l3[3], S##h3[0], S##h3[1], S##h3[2], S##h3[3]}, o[3], 0, 0, 0); } while (0)
#define FA_WAITL(n) do { asm volatile("s_waitcnt lgkmcnt(" #n ")" ::: "memory"); FA_SBAR(); } while (0)
    s16x4 Al0, Al1, Al2, Al3, Ah0, Ah1, Ah2, Ah3, Bl0, Bl1, Bl2, Bl3, Bh0, Bh1, Bh2, Bh3;
    FA_RD8(A, 0); FA_RD8(B, 1);
    FA_WAITL(8); FA_MM4(A, pa0); FA_SBAR();
    FA_RD8(A, 2);
    FA_WAITL(8); FA_MM4(B, pa1); FA_SBAR();
    FA_RD8(B, 3);
    FA_WAITL(8); FA_MM4(A, pa2); FA_SBAR();
    FA_WAITL(0); FA_MM4(B, pa3);
#undef FA_WAITL
#undef FA_MM4
#undef FA_RD8
#undef FA_TRRD
}
__device__ __forceinline__ bool softmax_tile(f32x16& p0, f32x16& p1, float& m_reg, float& l_reg, float& alpha, bf16x8& pa0, bf16x8& pa1, bf16x8& pa2, bf16x8& pa3, float coff = 0.f) {
    float mx[8];
#pragma unroll
    for (int r = 0; r < 8; ++r) mx[r] = fmaxf(fmaxf(p0[r], p0[r + 8]), fmaxf(p1[r], p1[r + 8]));
    float pmax = fmaxf(fmaxf(fmaxf(mx[0], mx[1]), fmaxf(mx[2], mx[3])), fmaxf(fmaxf(mx[4], mx[5]), fmaxf(mx[6], mx[7])));
    { auto rr = __builtin_amdgcn_permlane32_swap(__float_as_uint(pmax), __float_as_uint(pmax), false, false);
      pmax = fmaxf(__uint_as_float(rr[0]), __uint_as_float(rr[1])) + coff; }
    float mn; bool moved = false;
    if (__builtin_expect(__all((pmax - m_reg) <= 11.5f), 1)) { mn = m_reg; alpha = 1.f; }
    else { mn = fmaxf(m_reg, pmax); alpha = __builtin_amdgcn_exp2f(m_reg - mn); m_reg = mn; moved = true; }
    const float msub = mn - coff;
#pragma unroll
    for (int r = 0; r < 16; ++r) p0[r] = __builtin_amdgcn_exp2f(p0[r] - msub);
#pragma unroll
    for (int r = 0; r < 16; ++r) p1[r] = __builtin_amdgcn_exp2f(p1[r] - msub);
    float sm[8];
#pragma unroll
    for (int r = 0; r < 8; ++r) sm[r] = (p0[r] + p0[r + 8]) + (p1[r] + p1[r + 8]);
    float ps = ((sm[0] + sm[1]) + (sm[2] + sm[3])) + ((sm[4] + sm[5]) + (sm[6] + sm[7]));
    { auto rr = __builtin_amdgcn_permlane32_swap(__float_as_uint(ps), __float_as_uint(ps), false, false);
      ps = __uint_as_float(rr[0]) + __uint_as_float(rr[1]); }
    l_reg = l_reg * alpha + ps;
#define FA_PK4(P, B_, OUT) do { unsigned a0 = cvtpk(P[B_+0], P[B_+1]), a1 = cvtpk(P[B_+2], P[B_+3]);                          \
        unsigned b0 = cvtpk(P[B_+4], P[B_+5]), b1 = cvtpk(P[B_+6], P[B_+7]);                                             \
        auto r0 = __builtin_amdgcn_permlane32_swap(a0, b0, false, false); auto r1 = __builtin_amdgcn_permlane32_swap(a1, b1, false, false); \
        u32x4 w = {r0[0], r1[0], r0[1], r1[1]}; OUT = *reinterpret_cast<bf16x8*>(&w); } while (0)
    FA_PK4(p0, 0, pa0); FA_PK4(p0, 8, pa1); FA_PK4(p1, 0, pa2); FA_PK4(p1, 8, pa3);
#undef FA_PK4
    return moved;
}

template <int MODE>
__device__ __forceinline__ void attn_unit(const Frame& F, int l, int lane_in, int wid, int b, int h, int qb, unsigned* qctr, volatile LAS unsigned* qslot, int rs = 1, int ro = 0, int gp = 0) {
    int lane = lane_in; asm volatile("" : "+v"(lane));
    constexpr int QB = (MODE == 3) ? 128 : 256;
    constexpr int NQ = (MODE == 0) ? 12 : (MODE == 3) ? 4 : 8;
    constexpr bool TABLE = MODE != 0, BITS = MODE == 2, ROPE = MODE == 0, WIN = (MODE == 1 || MODE == 4);
    constexpr float C2 = ((MODE == 0) ? 0.07216878364870323f : (MODE == 3) ? 0.125f : 0.08838834764831845f) * LOG2E;
    const int tid = wid * 64 + lane, r32 = lane & 31, hi = lane >> 5;
    WS_LOCAL
    const int rb = b * 4096, q0 = qb * QB;
    const int map = (MODE == 3) ? (wid >> 2) : 0;
    const int qlo = q0 + ((MODE == 3) ? (wid & 3) * 32 : wid * 32);
    LAS char* const lds = (LAS char*)F.lds;
    LAS char* const V_lds = lds + L_V; LAS char* const K_lds = lds + L_K; LAS char* const KR_lds = lds + L_KR;
    LAS float* const li_l = (LAS float*)(lds + L_WS) + wid * 64; LAS float* const al_l = li_l + 32;
    LAS float* const tab = (LAS float*)(lds + L_TAB);
    const bf16_t* Qp; const bf16_t* Kp; const bf16_t* Vp; const bf16_t* KRp = nullptr; int kpitch;
    if (MODE == 0) { Qp = WSP(bf16_t, WS_QA) + (size_t)(rb + qlo + r32) * 768 + h * 192 + hi * 8; Kp = WSP(bf16_t, WS_KVA) + (size_t)rb * 1024 + h * 256; Vp = Kp + 128; KRp = WSP(bf16_t, WS_KR) + (size_t)rb * 64; kpitch = 1024; }
    else { const bf16_t* base = WSP(bf16_t, WS_QKV) + (size_t)((MODE == 2 ? 1 : MODE == 3 ? 2 : 0) * 3) * M * 512;
        const int rs_ = WIN ? rs : 1, ro_ = WIN ? ro : 0;
        Qp = base + (size_t)(rb + rs_ * (qlo + r32) + ro_) * 512 + h * 128 + map * 64 + hi * 8; Kp = base + (size_t)M * 512 + (size_t)(rb + ro_) * 512 + h * 128; Vp = base + (size_t)2 * M * 512 + (size_t)(rb + ro_) * 512 + h * 128; kpitch = 512 * rs_; }
    bf16x8 qr[NQ];
#pragma unroll
    for (int i = 0; i < NQ; ++i) qr[i] = *(const bf16x8*)(Qp + i * 16);
    const int j_hi = (q0 + QB - 1) / 64 + 1;
    const int j_lo = WIN ? ((q0 > 128) ? ((q0 - 128) >> 6) : 0) : 0;
    const int NT = j_hi - j_lo;
    float tv[9];
    if (TABLE) {
        const float* Tg = WIN ? WSP(float, WS_TB) + (gp * 4 + h) * 192 : WSP(float, WS_TCD) + ((MODE == 3 ? 4 : 0) + h) * 4096;
#pragma unroll
        for (int q = 0; q < 9; ++q) { const int d = 4095 - (tid + q * NWAVES * 64); const bool ok = d >= 0 && (!WIN || d <= 128); const float v = Tg[ok ? d : 0]; tv[q] = ok ? v : -__builtin_inff(); }
    }
    const int sr = tid >> 4, sc = (tid & 15) * 8, vst0 = v_st(sr, sc), vst1 = v_st(32 + sr, sc), kws = FA_KSWZ(sr, sc * 2);
    const int krow = tid >> 3, kch = tid & 7, krws = FA_KRSWZ(krow, kch * 16);
    const int vb0 = (int)(unsigned)(size_t)V_lds + v_rd_base(lane);
    const unsigned long long* bmp = WSP(unsigned long long, WS_BM) + (size_t)(rb + qlo + r32) * 64;
    bf16x8 st_k0, st_k1, st_v0, st_v1, st_kr; unsigned long long bm_cur = 0ull, bm_nxt = 0ull;
#define FA_STAGE_LOAD(k0_) do { const bf16_t* kp_ = Kp + (size_t)((k0_) + sr) * kpitch + sc; const bf16_t* vp_ = Vp + (size_t)((k0_) + sr) * kpitch + sc; \
        st_k0 = *(const bf16x8*)kp_; st_k1 = *(const bf16x8*)(kp_ + (size_t)32 * kpitch); st_v0 = *(const bf16x8*)vp_; st_v1 = *(const bf16x8*)(vp_ + (size_t)32 * kpitch); \
        if (ROPE) st_kr = *(const bf16x8*)(KRp + (size_t)((k0_) + krow) * 64 + kch * 8); if (BITS) bm_nxt = bmp[(k0_) >> 6]; } while (0)
#define FA_STAGE_WRITE(kbf, vbf) do { *(LAS bf16x8*)(K_lds + (kbf) * SHM_K + kws) = st_k0; *(LAS bf16x8*)(K_lds + (kbf) * SHM_K + kws + 32 * 256) = st_k1; \
        *(LAS bf16x8*)(V_lds + (vbf) * SHM_V + vst0) = st_v0; *(LAS bf16x8*)(V_lds + (vbf) * SHM_V + vst1) = st_v1; if (ROPE) *(LAS bf16x8*)(KR_lds + (kbf) * SHM_KR + krws) = st_kr; } while (0)
    float m_reg = -1e30f, l_reg = 0.f; f32x16 o[4] = {};
    const bool grpB = wid >= 4;
    FA_STAGE_LOAD(j_lo * 64);
    {
#pragma unroll
        for (int i = 0; i < NQ; ++i) { u32x4 w = __builtin_bit_cast(u32x4, qr[i]);
            w.x = cvtpk(bf_lo(w.x) * C2, bf_hi(w.x) * C2); w.y = cvtpk(bf_lo(w.y) * C2, bf_hi(w.y) * C2); w.z = cvtpk(bf_lo(w.z) * C2, bf_hi(w.z) * C2); w.w = cvtpk(bf_lo(w.w) * C2, bf_hi(w.w) * C2);
            qr[i] = __builtin_bit_cast(bf16x8, w); }
    }
    if (TABLE) {
#pragma unroll
        for (int q = 0; q < 9; ++q) { const int i = tid + q * NWAVES * 64; if (i < TAB_N) tab[i] = tv[q]; }
    }
    asm volatile("s_waitcnt vmcnt(0)" ::: "memory"); FA_STAGE_WRITE(0, 0); bm_cur = bm_nxt;
    __syncthreads();
    float alpha = 1.f; bf16x8 pa0 = {}, pa1 = {}, pa2 = {}, pa3 = {};
    int vbc = 0, vbp = 2;
    bool act_prev = false;
#pragma unroll 1
    for (int t = 0; t < NT; ++t) {
        const int k0 = (j_lo + t) * 64; const bool more = t + 1 < NT; const int kb = t & 1; const int vbn = (vbc == NVB - 1) ? 0 : vbc + 1;
        if (more) FA_STAGE_LOAD(k0 + 64);
        if (grpB && act_prev) { pv_tile(o, vb0 + vbp * SHM_V, pa0, pa1, pa2, pa3); FA_SBAR(); }
        const bool act = (k0 <= qlo + 31) && (!WIN || k0 + 63 >= qlo - 128);
        if (act) {
        f32x16 p0 = {}, p1 = {};
        if (MODE == 3) { if (map == 0) qkt_main<0, 4>(p0, p1, K_lds + kb * SHM_K, r32, hi, qr); else qkt_main<4, 4>(p0, p1, K_lds + kb * SHM_K, r32, hi, qr); }
        else qkt_main<0, 8>(p0, p1, K_lds + kb * SHM_K, r32, hi, qr);
        if (ROPE) qkt_rope(p0, p1, KR_lds + kb * SHM_KR, r32, hi, qr + (ROPE ? 8 : 0));
        const int dq = qlo + r32 - k0 - 4 * hi;
        float coff = 0.f;
        if (TABLE) {
            if (!WIN && qlo - (k0 + 63) >= 1513) coff = tab[0];
            else { const LAS float* tp = tab + (4095 - dq);
#pragma unroll
                for (int r = 0; r < 16; ++r) { const int c = (r & 3) + 8 * (r >> 2); p0[r] += tp[c]; p1[r] += tp[c + 32]; } }
            if (BITS) { const unsigned wlo = (unsigned)bm_cur >> (4 * hi), whi = (unsigned)(bm_cur >> 32) >> (4 * hi);
#pragma unroll
                for (int r = 0; r < 16; ++r) { const int c = (r & 3) + 8 * (r >> 2);
                    const unsigned m0_ = (unsigned)__builtin_amdgcn_sbfe(wlo, c, 1), m1_ = (unsigned)__builtin_amdgcn_sbfe(whi, c, 1);
                    p0[r] = __uint_as_float((__float_as_uint(p0[r]) & m0_) | (0xFF800000u & ~m0_)); p1[r] = __uint_as_float((__float_as_uint(p1[r]) & m1_) | (0xFF800000u & ~m1_)); } }
        } else {
            if (k0 + 63 > qlo) {
#pragma unroll
                for (int r = 0; r < 16; ++r) { const int c = (r & 3) + 8 * (r >> 2);
                    if (dq - c < 0) p0[r] = -__builtin_inff(); if (dq - c - 32 < 0) p1[r] = -__builtin_inff(); } }
        }
        const bool moved = softmax_tile(p0, p1, m_reg, l_reg, alpha, pa0, pa1, pa2, pa3, coff);
        if (moved) { if (hi == 0) al_l[r32] = alpha; asm volatile("s_waitcnt lgkmcnt(0)" ::: "memory");
#pragma unroll
            for (int r = 0; r < 16; ++r) { const float a_ = al_l[crow(r, hi)];
#pragma unroll
                for (int d_ = 0; d_ < 4; ++d_) o[d_][r] *= a_; } }
        FA_SBAR();
        if (!grpB) { pv_tile(o, vb0 + vbc * SHM_V, pa0, pa1, pa2, pa3); FA_SBAR(); }
        }
        act_prev = act;
        if (more) { asm volatile("s_waitcnt vmcnt(0)" ::: "memory"); FA_STAGE_WRITE(kb ^ 1, vbn); bm_cur = bm_nxt; }
        __syncthreads();
        vbp = vbc; vbc = vbn;
    }
    if (grpB && act_prev) pv_tile(o, vb0 + vbp * SHM_V, pa0, pa1, pa2, pa3);
    __syncthreads();
#undef FA_STAGE_LOAD
#undef FA_STAGE_WRITE
    unsigned q_next = 0u; if (tid == 0) q_next = atomicAdd(qctr, 1u);
    u32x4 gv[8]; u32x4 p1v[8], p2v[8]; float e1 = 0.f, e2 = 0.f;
    if (MODE != 4 && (MODE != 3 || map == 0)) {
        const bf16_t* const Mr = WSP(bf16_t, WS_MIXED) + (size_t)(rb + qlo) * 2048 + (MODE == 1 ? 512 : MODE * 512) + h * 128;
#pragma unroll
        for (int i = 0; i < 8; ++i) { const int c = lane + 64 * i, row = c >> 4, col8 = (c & 15) * 8; gv[i] = *(const u32x4*)(Mr + (size_t)row * 2048 + col8); }
        if (MODE == 1) {
            const bf16_t* const P1 = WSP(bf16_t, WS_PB) + (size_t)(rb + qlo) * 512 + h * 128; const bf16_t* const P2 = P1 + (size_t)M * 512;
#pragma unroll
            for (int i = 0; i < 8; ++i) { const int c = lane + 64 * i, row = c >> 4, col8 = (c & 15) * 8; p1v[i] = *(const u32x4*)(P1 + (size_t)row * 512 + col8); p2v[i] = *(const u32x4*)(P2 + (size_t)row * 512 + col8); }
            const size_t rowg = (size_t)(rb + qlo + r32);
            e1 = WSP(float, WS_LSE)[rowg * 4 + h]; e2 = WSP(float, WS_LSE)[((size_t)M + rowg) * 4 + h];
        }
    }
    if (hi == 0) li_l[r32] = l_reg; asm volatile("s_waitcnt lgkmcnt(0)" ::: "memory");
    float rli[16];
#pragma unroll
    for (int r = 0; r < 16; ++r) rli[r] = __builtin_amdgcn_rcpf(li_l[crow(r, hi)]);
#pragma unroll
    for (int d0 = 0; d0 < 4; ++d0)
#pragma unroll
        for (int r = 0; r < 16; ++r) o[d0][r] *= rli[r];
    if (MODE == 3) {
        LAS float* xb = (LAS float*)lds + (size_t)(wid & 3) * 4096 + lane;
        if (map == 1) {
#pragma unroll
            for (int d0 = 0; d0 < 4; ++d0)
#pragma unroll
                for (int r = 0; r < 16; ++r) xb[(d0 * 16 + r) * 64] = o[d0][r];
        }
        __syncthreads();
        if (map == 0) {
            const float lam = WSP(float, WS_CONST)[l];
            const float li = (l == 0) ? 0.2f : 0.35550906759096926f;
#pragma unroll
            for (int d0 = 0; d0 < 4; ++d0)
#pragma unroll
                for (int r = 0; r < 16; ++r) o[d0][r] -= lam * xb[(d0 * 16 + r) * 64];
            const float* gs = FIN(15) + l * 128;
            float g4[4];
#pragma unroll
            for (int d0 = 0; d0 < 4; ++d0) g4[d0] = gs[d0 * 32 + r32] * (1.0f - li);
#pragma unroll
            for (int r = 0; r < 16; ++r) {
                float ss = (o[0][r] * o[0][r] + o[1][r] * o[1][r]) + (o[2][r] * o[2][r] + o[3][r] * o[3][r]);
                DPP_ADD(ss, 0xB1); DPP_ADD(ss, 0x4E); DPP_ADD(ss, 0x141); DPP_ADD(ss, 0x140);
                { auto rr_ = __builtin_amdgcn_permlane16_swap(__float_as_uint(ss), __float_as_uint(ss), false, false); ss = __uint_as_float(rr_[0]) + __uint_as_float(rr_[1]); }
                const float rs = __builtin_amdgcn_rsqf(ss * (1.0f / 128.0f) + 1e-6f);
#pragma unroll
                for (int d0 = 0; d0 < 4; ++d0) o[d0][r] *= rs * g4[d0];
            }
        }
    }
    if (MODE != 3 || map == 0) {
        LAS char* const stg = lds + ((MODE == 3) ? 65536 + wid * 8192 : wid * 8192);
#pragma unroll
        for (int r = 0; r < 16; ++r) { const int orow = crow(r, hi);
#pragma unroll
            for (int d0 = 0; d0 < 4; ++d0) { const float v = o[d0][r];
                const float vn = __builtin_bit_cast(float, __builtin_amdgcn_update_dpp(0, __builtin_bit_cast(int, v), 0xB1, 0xF, 0xF, true));
                if ((r32 & 1) == 0) *(LAS unsigned*)(stg + (orow * 128 + d0 * 32 + r32) * 2) = cvtpk(v, vn); } }
        if (MODE == 4) {
            asm volatile("s_waitcnt lgkmcnt(0)" ::: "memory");
            bf16_t* const Pw = WSP(bf16_t, WS_PB) + (size_t)(gp - 1) * M * 512 + h * 128;
#pragma unroll
            for (int i = 0; i < 8; ++i) { const int c = lane + 64 * i, row = c >> 4, col8 = (c & 15) * 8;
                *(u32x4*)(Pw + (size_t)(rb + rs * (qlo + row) + ro) * 512 + col8) = *(const LAS u32x4*)(stg + row * 256 + col8 * 2); }
            if (hi == 0) WSP(float, WS_LSE)[((size_t)(gp - 1) * M + (rb + rs * (qlo + r32) + ro)) * 4 + h] = m_reg + __builtin_amdgcn_logf(l_reg);
        } else if (MODE == 1) {
            LAS float* const wts = (LAS float*)(lds + 65536 + wid * 512);
            if (hi == 0) {
                const float e0 = m_reg + __builtin_amdgcn_logf(l_reg);
                const float mx = fmaxf(fmaxf(e0, e1), e2);
                const float w0 = __builtin_amdgcn_exp2f(e0 - mx), w1 = __builtin_amdgcn_exp2f(e1 - mx), w2 = __builtin_amdgcn_exp2f(e2 - mx);
                const float inv = __builtin_amdgcn_rcpf(w0 + w1 + w2);
                *(LAS f32x4*)(wts + r32 * 4) = (f32x4){w0 * inv, w1 * inv, w2 * inv, 0.f};
            }
            asm volatile("s_waitcnt lgkmcnt(0)" ::: "memory");
            bf16_t* const Mw = WSP(bf16_t, WS_MIXED) + (size_t)(rb + qlo) * 2048 + 512 + h * 128;
            u32x4 ov[8];
#pragma unroll
            for (int i = 0; i < 8; ++i) { const int c = lane + 64 * i, row = c >> 4, col8 = (c & 15) * 8; ov[i] = *(const LAS u32x4*)(stg + row * 256 + col8 * 2); }
#pragma unroll
            for (int i = 0; i < 8; ++i) { const int c = lane + 64 * i, row = c >> 4, col8 = (c & 15) * 8;
                const f32x4 w = *(const LAS f32x4*)(wts + row * 4);
#define FA_MIX(O, A, B, G, sel) ((w[0] * sel(O) + w[1] * sel(A) + w[2] * sel(B)) * sel(G))
                u32x4 q;
                q.x = cvtpk(FA_MIX(ov[i].x, p1v[i].x, p2v[i].x, gv[i].x, bf_lo), FA_MIX(ov[i].x, p1v[i].x, p2v[i].x, gv[i].x, bf_hi));
                q.y = cvtpk(FA_MIX(ov[i].y, p1v[i].y, p2v[i].y, gv[i].y, bf_lo), FA_MIX(ov[i].y, p1v[i].y, p2v[i].y, gv[i].y, bf_hi));
                q.z = cvtpk(FA_MIX(ov[i].z, p1v[i].z, p2v[i].z, gv[i].z, bf_lo), FA_MIX(ov[i].z, p1v[i].z, p2v[i].z, gv[i].z, bf_hi));
                q.w = cvtpk(FA_MIX(ov[i].w, p1v[i].w, p2v[i].w, gv[i].w, bf_lo), FA_MIX(ov[i].w, p1v[i].w, p2v[i].w, gv[i].w, bf_hi));
#undef FA_MIX
                *(u32x4*)(Mw + (size_t)row * 2048 + col8) = q; }
        } else {
        asm volatile("s_waitcnt lgkmcnt(0)" ::: "memory");
        bf16_t* const Mw = WSP(bf16_t, WS_MIXED) + (size_t)(rb + qlo) * 2048 + MODE * 512 + h * 128;
        u32x4 ov[8];
#pragma unroll
        for (int i = 0; i < 8; ++i) { const int c = lane + 64 * i, row = c >> 4, col8 = (c & 15) * 8; ov[i] = *(const LAS u32x4*)(stg + row * 256 + col8 * 2); }
#pragma unroll
        for (int i = 0; i < 8; ++i) { const int c = lane + 64 * i, row = c >> 4, col8 = (c & 15) * 8;
            u32x4 w;
            w.x = cvtpk(bf_lo(ov[i].x) * bf_lo(gv[i].x), bf_hi(ov[i].x) * bf_hi(gv[i].x)); w.y = cvtpk(bf_lo(ov[i].y) * bf_lo(gv[i].y), bf_hi(ov[i].y) * bf_hi(gv[i].y));
            w.z = cvtpk(bf_lo(ov[i].z) * bf_lo(gv[i].z), bf_hi(ov[i].z) * bf_hi(gv[i].z)); w.w = cvtpk(bf_lo(ov[i].w) * bf_lo(gv[i].w), bf_hi(ov[i].w) * bf_hi(gv[i].w));
            *(u32x4*)(Mw + (size_t)row * 2048 + col8) = w; }
        }
    }
    if (tid == 0) *qslot = q_next;
    __syncthreads();
}
#undef FA_KSWZ
#undef FA_KRSWZ
#undef FA_SBAR
}

__device__ __forceinline__ int queue_next(unsigned* ctr, volatile LAS unsigned* slot, int tid) {
    if (tid == 0) *slot = atomicAdd(ctr, 1u);
    __syncthreads();
    const int v = (int)*slot;
    __syncthreads();
    return v;
}
__device__ __forceinline__ void p_attn_group1(const Frame& F, int l) {
    PHASE_LOCALS
    unsigned* ctr = (unsigned*)(ws_l + WS_CTL + 16384 + (l * 4 + 3) * 256);
    volatile LAS unsigned* slot = (volatile LAS unsigned*)(F.lds + MISC_OFF) + 16;
    int it = queue_next(ctr, slot, tid);
    while (it < 1024) {
        const int bh = it & 15;
        if (it < 512) fa::attn_unit<3>(F, l, lane, wave, bh >> 2, bh & 3, 31 - (it >> 4), ctr, slot);
        else { const int j = it - 512; const bool p4 = j < 256;
            fa::attn_unit<4>(F, l, lane, wave, bh >> 2, bh & 3, p4 ? 3 - (j >> 6) : 0, ctr, slot, p4 ? 4 : 16, p4 ? (j >> 4) & 3 : (j - 256) >> 4, p4 ? 1 : 2); }
        it = (int)*slot;
    }
    __syncthreads();
}
__device__ __forceinline__ void p_attn_group2(const Frame& F, int l) {
    PHASE_LOCALS
    unsigned* ctr = (unsigned*)(ws_l + WS_CTL + 16384 + (l * 4 + 0) * 256);
    volatile LAS unsigned* slot = (volatile LAS unsigned*)(F.lds + MISC_OFF) + 16;
    int it = queue_next(ctr, slot, tid);
    while (it < 768) {
        const int bh = it & 15, qb = 15 - ((it >> 4) & 15);
        if (it < 256) fa::attn_unit<0>(F, l, lane, wave, bh >> 2, bh & 3, qb, ctr, slot);
        else if (it < 512) fa::attn_unit<2>(F, l, lane, wave, bh >> 2, bh & 3, qb, ctr, slot);
        else fa::attn_unit<1>(F, l, lane, wave, bh >> 2, bh & 3, qb, ctr, slot);
        it = (int)*slot;
    }
    __syncthreads();
}

namespace ix {
using fa::bf16x8; using fa::f32x16;
constexpr int KB = 3;
constexpr int L_Q = 0, L_W = 65536;
__device__ __forceinline__ void index_item(const Frame& F, int lane_in, int wid, int b, int qi, float* scr, int pitch  ) {
    int lane = lane_in; asm volatile("" : "+v"(lane));
    WS_LOCAL
    const int tid = wid * 64 + lane, r32 = lane & 31, hi = lane >> 5;
    const int rb = b * 4096, q0 = qi * 32;
    LAS char* const lds = (LAS char*)F.lds;
    {
        const int r = tid >> 4;
        const bf16_t* src = WSP(bf16_t, WS_IDXQ) + (size_t)(rb + q0 + r) * 1024;
#pragma unroll
        for (int i = 0; i < 8; ++i) { const int c = (tid & 15) + 16 * i; const bf16x8 v = *(const bf16x8*)(src + c * 8); *(LAS bf16x8*)(lds + L_Q + r * 2048 + ((c ^ (r & 15)) << 4)) = v; }
        ((LAS float*)(lds + L_W))[(tid & 15) * 32 + r] = WSP(float, WS_IDXW)[(size_t)(rb + q0 + r) * 16 + (tid & 15)];
    }
    __syncthreads();
    const int nkb = qi + 1;
    unsigned abase[4];
#pragma unroll
    for (int s = 0; s < 4; ++s) abase[s] = (unsigned)(size_t)(lds + L_Q) + r32 * 2048 + (((2 * s + hi) ^ (r32 & 15)) << 4);
    const bf16_t* kbase = WSP(bf16_t, WS_IDXK) + (size_t)(rb + r32) * 64 + 8 * hi;
    const LAS float* wrow = (const LAS float*)(lds + L_W) + r32;
#define IX_LDA(dst, hh) do { _Pragma("unroll") for (int s = 0; s < 4; ++s) dst[s] = *(const LAS bf16x8*)(size_t)((abase[s] ^ ((unsigned)((hh) & 1) << 7)) + (unsigned)((hh) >> 1) * 256u); } while (0)
#define IX_RELU(x) __int_as_float(max(__float_as_int(x), 0))
#define IX_BLKA(MMA, ACC, AH, WV) do { _Pragma("unroll") for (int s = 0; s < 4; ++s) { \
        if (MMA) { dA0 = __builtin_amdgcn_mfma_f32_32x32x16_bf16(kf[0][s], AH[s], s == 0 ? f32x16{} : dA0, 0, 0, 0); dA1 = __builtin_amdgcn_mfma_f32_32x32x16_bf16(kf[1][s], AH[s], s == 0 ? f32x16{} : dA1, 0, 0, 0); } \
        if (ACC) { _Pragma("unroll") for (int i = 4 * s; i < 4 * s + 4; ++i) score[2][i] = fmaf(IX_RELU(dB[i]), WV, score[2][i]); } } } while (0)
#define IX_BLKB(AH, WV) do { _Pragma("unroll") for (int s = 0; s < 4; ++s) { \
        dB = __builtin_amdgcn_mfma_f32_32x32x16_bf16(kf[2][s], AH[s], s == 0 ? f32x16{} : dB, 0, 0, 0); \
        _Pragma("unroll") for (int i = 4 * s; i < 4 * s + 4; ++i) { score[0][i] = fmaf(IX_RELU(dA0[i]), WV, score[0][i]); score[1][i] = fmaf(IX_RELU(dA1[i]), WV, score[1][i]); } } } while (0)
    for (int kb0 = wid * KB; kb0 < nkb; kb0 += NWAVES * KB) {
        bf16x8 kf[KB][4];
#pragma unroll
        for (int kbi = 0; kbi < KB; ++kbi)
#pragma unroll
            for (int s = 0; s < 4; ++s) { kf[kbi][s] = (bf16x8){0, 0, 0, 0, 0, 0, 0, 0}; if (kb0 + kbi < nkb) kf[kbi][s] = *(const bf16x8*)(kbase + (size_t)(kb0 + kbi) * 32 * 64 + 16 * s); }
        f32x16 score[KB];
#pragma unroll
        for (int kbi = 0; kbi < KB; ++kbi) score[kbi] = f32x16{};
        bf16x8 a0[4], a1[4]; f32x16 dA0, dA1, dB; float w0, w1;
        IX_LDA(a0, 0); w0 = wrow[0]; IX_LDA(a1, 1); w1 = wrow[32];
        IX_BLKA(true, false, a0, w0);
#pragma unroll 1
        for (int h = 0; h < 14; h += 2) {
            IX_BLKB(a0, w0);
            IX_LDA(a0, h + 2);
            IX_BLKA(true, true, a1, w0);
            w0 = wrow[(h + 2) * 32];
            IX_BLKB(a1, w1);
            IX_LDA(a1, h + 3);
            IX_BLKA(true, true, a0, w1);
            w1 = wrow[(h + 3) * 32];
        }
        IX_BLKB(a0, w0);
        IX_BLKA(true, true, a1, w0);
        IX_BLKB(a1, w1);
        IX_BLKA(false, true, a0, w1);
        int kbs = kb0, pit = pitch; asm volatile("" : "+s"(kbs), "+s"(pit));
#pragma unroll
        for (int kbi = 0; kbi < KB; ++kbi) {
            if (kbs + kbi < nkb) {
                float* dst = scr + (size_t)r32 * pit + (size_t)(kbs + kbi) * 32 + 4 * hi;
#pragma unroll
                for (int g = 0; g < 4; ++g) *(f32x4*)(dst + 8 * g) = (f32x4){score[kbi][4 * g], score[kbi][4 * g + 1], score[kbi][4 * g + 2], score[kbi][4 * g + 3]};
            }
        }
    }
#undef IX_LDA
#undef IX_RELU
#undef IX_BLKA
#undef IX_BLKB
    asm volatile("s_waitcnt vmcnt(0)" ::: "memory");
    __syncthreads();
    __builtin_amdgcn_fence(__ATOMIC_ACQUIRE, "agent");
    asm volatile("s_waitcnt vmcnt(0)" ::: "memory");
#pragma unroll 1
    for (int rr = 0; rr < 4; ++rr) {
        const int row = wid * 4 + rr, pos = q0 + row;
        const float* srow = scr + (size_t)(row * pitch) + lane;
        const int js = pos >> 6;
        float sv[64];
#pragma unroll
        for (int g = 0; g < 8; ++g) {
            if (64 * 8 * g <= pos) {
#pragma unroll
                for (int q = 0; q < 8; ++q) sv[8 * g + q] = srow[64 * (8 * g + q)];
            } else {
#pragma unroll
                for (int q = 0; q < 8; ++q) sv[8 * g + q] = 0.f;
            }
        }
        unsigned uk[64];
#pragma unroll
        for (int g = 0; g < 8; ++g) {
            if (8 * g + 7 < js) {
#pragma unroll
                for (int j = 8 * g; j < 8 * g + 8; ++j) uk[j] = score_key(sv[j]);
            } else if (8 * g <= js) {
#pragma unroll
                for (int j = 8 * g; j < 8 * g + 8; ++j) uk[j] = (64 * j + lane <= pos) ? score_key(sv[j]) : 0u;
            } else {
#pragma unroll
                for (int j = 8 * g; j < 8 * g + 8; ++j) uk[j] = 0u;
            }
        }
        select_row(uk, pos, WSP(unsigned long long, WS_BM) + (size_t)(rb + pos) * 64, lane, (LAS unsigned*)(lds + L_W + 4096) + wid * 64);
    }
    __syncthreads();
}
}
__device__ __forceinline__ void p_index_fast(const Frame& F) {
    PHASE_LOCALS
    for (int w = bid; w < 256; w += G_l) {
    const int a = (w >> 2) & 63, b = w & 3, nkbig = 128 - a;
    float* scr = (float*)(ws_l + WS_SCR + (size_t)16384 * (128 * a - (a * (a - 1)) / 2) + (size_t)b * nkbig * 4096);
    ix::index_item(F, lane, wave, b, 127 - a, scr, 32 * nkbig);
    ix::index_item(F, lane, wave, b, a, scr, 32 * nkbig);
    }
}
template <int PH_LO, int PH_HI>
__global__ void __launch_bounds__(NWAVES * 64, 2) fwd_kernel(Args args) {
    extern __shared__ __attribute__((aligned(16))) unsigned char lds_raw[];
    Frame F;
    F.lds = (LAS unsigned char*)lds_raw;
    F.wave = __builtin_amdgcn_readfirstlane((int)threadIdx.x >> 6);
    F.G = gridDim.x; { const int bx = blockIdx.x; F.vcu = (F.G % 8 == 0) ? (bx % 8) * (F.G / 8) + bx / 8 : bx; }
    F.a = &args; F.out = args.out; F.ws = args.ws;
    volatile LAS unsigned* MISC = (volatile LAS unsigned*)(F.lds + MISC_OFF);
    if (threadIdx.x < 64) MISC[threadIdx.x] = 0u;
    __syncthreads();
    constexpr int lo = PH_LO, hi = PH_HI;
    constexpr bool use_bar = (hi - lo) > 1;
    XcdBarrier bar; bar.bar = (unsigned*)(F.ws + WS_CTL); bar.x = 0; bar.st = MISC + 8;
    if (use_bar) bar = xcd_barrier_post((unsigned*)(F.ws + WS_CTL), MISC + 8);
    bar.wave0 = F.wave;
#define IN(k) (lo <= (k) && (k) < hi)
#define SEAM(k) do { if constexpr (IN(k) && IN((k) + 1)) { XcdBarrier b2_ = bar; asm volatile("" : "+s"(b2_.bar), "+s"(b2_.x)); xcd_barrier(b2_); } } while (0)
    if constexpr (IN(0)) { p0_prologue(F); } SEAM(0);
    if constexpr (IN(1)) { p_pre0(F); } SEAM(1);
#define LAYER_PHASES(l_)                                                                                                                                      \
    { constexpr int l = (l_); constexpr int pb = 2 + 5 * l;                                                                                                    \
        if constexpr (IN(pb))     { p_gemm1(F, l); } SEAM(pb);                                                                           \
        if constexpr (IN(pb + 1)) { p_upq(F, l); __syncthreads(); p_upkv(F, l); __syncthreads(); p_index_fast(F); __syncthreads();                             \
                                    p_attn_group1(F, l); } SEAM(pb + 1);                        \
        if constexpr (IN(pb + 2)) { p_attn_group2(F, l); } SEAM(pb + 2);                                          \
        if constexpr (IN(pb + 3)) { p_gemm2(F, l); } SEAM(pb + 3);                                                                      \
        if constexpr (IN(pb + 4)) { p_post(F, l); } SEAM(pb + 4);                                                        \
    }
    LAYER_PHASES(0)
    LAYER_PHASES(1)
}

extern "C" void kernel_launch(void* const* d_in, const int* in_sizes, int n_in, void* d_out, int out_size, void* d_ws, size_t ws_size, hipStream_t stream) {
    static int grid = 0;
    if (grid == 0) {
        if (n_in != 18 || out_size != M * DM || ws_size < WS_END) { fprintf(stderr, "kernel_launch: unexpected problem (n_in %d, out %d, ws %zu < %zu)\n", n_in, out_size, ws_size, (size_t)WS_END); grid = -1; return; }
        int dev = 0, cus = 0, per_cu = 0;
        if (hipGetDevice(&dev) != hipSuccess || hipDeviceGetAttribute(&cus, hipDeviceAttributeMultiprocessorCount, dev) != hipSuccess) { grid = -1; return; }
        if (hipFuncSetAttribute((const void*)fwd_kernel<0, N_PHASES>, hipFuncAttributeMaxDynamicSharedMemorySize, LDS_BYTES) != hipSuccess) { fprintf(stderr, "kernel_launch: hipFuncSetAttribute failed\n"); grid = -1; return; }
        if (hipOccupancyMaxActiveBlocksPerMultiprocessor(&per_cu, (const void*)fwd_kernel<0, N_PHASES>, NWAVES * 64, LDS_BYTES) != hipSuccess || per_cu < 1) { fprintf(stderr, "kernel_launch: occupancy query reports %d\n", per_cu); }
        (void)hipGetLastError();
        grid = cus;
    }
    if (grid < 0) return;
    if (hipMemsetAsync((char*)d_ws, 0, ZERO_BYTES, stream) != hipSuccess) { fprintf(stderr, "kernel_launch: memset failed\n"); return; }
    Args a{};
    for (int i = 0; i < 18; ++i) a.in[i] = (const float*)d_in[i];
    a.out = (float*)d_out; a.ws = (unsigned char*)d_ws;
    a.ph_lo = 0; a.ph_hi = N_PHASES;
    hipLaunchKernelGGL((fwd_kernel<0, N_PHASES>), dim3(grid), dim3(NWAVES * 64), LDS_BYTES, stream, a);
    const hipError_t le = hipPeekAtLastError();
    if (le != hipSuccess) fprintf(stderr, "kernel_launch: launch failed: %s\n", hipGetErrorName(le));
}
```

```cpp
#include <hip/hip_runtime.h>
#include <cstdio>
#include <cstdint>
constexpr int M = 16384, NW1 = 8704;
constexpr size_t al256(size_t x) { return (x + 255) & ~(size_t)255; }
constexpr size_t WS_CTL = 0;
constexpr size_t CTL_BYTES = 65536;
constexpr size_t WS_MOD = WS_CTL + CTL_BYTES;
constexpr size_t WS_SSQ = WS_MOD + al256(2 * 4 * 6144 * 4);
constexpr size_t WS_SSKV = WS_SSQ + (size_t)M * 8 * 4;
constexpr size_t WS_SSEND = WS_SSKV + (size_t)M * 4 * 4;
constexpr size_t ZERO_BYTES = CTL_BYTES;
constexpr size_t WS_CONST = WS_SSEND;
constexpr size_t WS_ROPE = WS_CONST + 256;
constexpr size_t WS_TCD = WS_ROPE + (size_t)4096 * 32 * 8;
constexpr size_t WS_TB = WS_TCD + (size_t)8 * 4096 * 4;
constexpr size_t WS_WTOUT = WS_TB + (size_t)4 * 2560 * 4;
constexpr size_t WS_WTUQ = WS_WTOUT + (size_t)2 * 2048 * 2048 * 2;
constexpr size_t WS_WTUKV = WS_WTUQ + (size_t)2 * 768 * 384 * 2;
constexpr size_t WTIN_BYTES = (size_t)NW1 * 2048 * 2;
constexpr size_t WS_WTIN1 = WS_WTUKV + (size_t)2 * 1024 * 256 * 2;
constexpr size_t WS_WTIN0 = WS_WTIN1 + WTIN_BYTES;
constexpr size_t WS_H = WS_WTIN0 + WTIN_BYTES;
constexpr size_t WS_SCR = WS_WTIN0;
constexpr size_t SCR_BYTES = WTIN_BYTES + (size_t)M * 2048 * 2;
static_assert((size_t)16384 * 6176 <= SCR_BYTES, "indexer scratch: 256 compact slots");
constexpr size_t WS_MIXED = WS_H + (size_t)M * 2048 * 2;
constexpr size_t WS_CKV = WS_MIXED + (size_t)M * 2048 * 2;
constexpr size_t WS_CQ = WS_CKV + (size_t)M * 256 * 2;
constexpr size_t WS_KR = WS_CQ + (size_t)M * 384 * 2;
constexpr size_t WS_IDXK = WS_KR + (size_t)M * 64 * 2;
constexpr size_t WS_IDXW = WS_IDXK + (size_t)M * 64 * 2;
constexpr size_t WS_IDXQ = WS_IDXW + (size_t)M * 16 * 4;
constexpr size_t WS_QKV = WS_IDXQ + (size_t)M * 1024 * 2;
constexpr size_t WS_QA = WS_QKV + (size_t)9 * M * 512 * 2;
constexpr size_t WS_KVA = WS_QA + (size_t)M * 768 * 2;
constexpr size_t WS_BM = WS_KVA + (size_t)M * 1024 * 2;
constexpr size_t WS_PB = WS_BM + (size_t)M * 64 * 8;
constexpr size_t WS_LSE = WS_PB + (size_t)2 * M * 512 * 2;
constexpr size_t WS_END = WS_LSE + (size_t)2 * M * 4 * 4;
constexpr size_t WS_Y = WS_QKV;
static_assert((size_t)M * 2048 * 4 <= (size_t)9 * M * 512 * 2, "Y overlay");

namespace pg8 { constexpr size_t OFF_CKV = WS_CKV, OFF_CQ = WS_CQ, OFF_KR = WS_KR, OFF_IDXK = WS_IDXK, OFF_IDXQ = WS_IDXQ, OFF_QKV = WS_QKV, OFF_MIXED = WS_MIXED, OFF_IDXW = WS_IDXW,
    OFF_SSQ = WS_SSQ, OFF_SSKV = WS_SSKV, OFF_ROPE = WS_ROPE, OFF_QA = WS_QA, OFF_KVA = WS_KVA, OFF_Y = WS_Y; }
__device__ __forceinline__ int fresh_lane() { unsigned ones = ~0u; asm volatile("" : "+s"(ones)); return (int)__builtin_amdgcn_mbcnt_hi(ones, __builtin_amdgcn_mbcnt_lo(ones, 0u)); }
namespace pg8 {
#define PG8_LAS __attribute__((address_space(3)))
typedef unsigned short bf16_t;
typedef short bf16x8 __attribute__((ext_vector_type(8)));
typedef float f32x4 __attribute__((ext_vector_type(4)));
typedef unsigned u32x4 __attribute__((ext_vector_type(4)));
constexpr int BM = 256, BK = 64, HALF = 128, HTB = HALF * BK * 2  , STAGE_BYTES = 8 * HTB, NXCD = 8, WGM = 8;

__host__ __device__ __forceinline__ int lds_byte(int r, int c) { const int st = (r >> 4) * 2 + (c >> 5), rr = r & 15, cc = c & 31, ob = rr * 64 + cc * 2; return st * 1024 + (ob ^ (((ob >> 9) & 1) << 5)); }
__host__ __device__ __forceinline__ void stage_rc(int b, int& R, int& C) { const int st = b / 1024, sb = b % 1024, swz = sb ^ (((sb >> 9) & 1) << 5); R = (st >> 1) * 16 + swz / 64; C = (st & 1) * 32 + (swz % 64) / 2; }
__host__ __device__ __forceinline__ int perm32(int rho) { const int n = rho >> 4, i = rho & 15; return 8 * (i >> 2) + 4 * n + (i & 3); }

struct Unit { int pm, pn, hs; };
struct Gemm { const bf16_t* A; const bf16_t* Bt; int M, N, K; };

struct StaticOrder {
    int nM, nN, nwg, G, c;
    __host__ __device__ void init(int M, int N, int G_, int c_) { nM = M / BM; nN = N / BM; nwg = nM * nN; G = G_; c = c_; }
    __host__ __device__ bool next(int i, Unit& u) const {
        const long L = (long)i * G + c; if (L >= nwg) return false;
        int wgid = (int)L; { const int q = nwg / NXCD, r = nwg % NXCD, xcd = wgid % NXCD, off = wgid / NXCD; wgid = (xcd < r ? xcd * (q + 1) : r * (q + 1) + (xcd - r) * q) + off; }
        const int nig = WGM * nN, gid = wgid / nig, fm = gid * WGM, gsz = (nM - fm) < WGM ? (nM - fm) : WGM;
        u.pm = fm + ((wgid % nig) % gsz); u.pn = ((wgid % nig) / gsz + 4 * gid) % nN; u.hs = 0; return true;
    }
    __device__ __forceinline__ void a_ready(const Unit&) const {}
    __device__ __forceinline__ void done(const Unit&) const {}
};
struct TailOrder {
    int c;
    __device__ __forceinline__ bool next(int i, Unit& u) const { if (i > 0) return false; const int g = c & 7, w = c >> 3; u.pm = 8 * g + ((w >> 1) & 7); u.pn = 32 + (w >> 4); u.hs = w & 1; return true; }
    __device__ __forceinline__ void a_ready(const Unit&) const {}
    __device__ __forceinline__ void done(const Unit&) const {}
};

__device__ __forceinline__ unsigned cvt_pk_bf16(float lo, float hi) { unsigned r; asm volatile("v_cvt_pk_bf16_f32 %0, %1, %2" : "=v"(r) : "v"(lo), "v"(hi)); return r; }
typedef float f32x2 __attribute__((ext_vector_type(2)));
__device__ __forceinline__ float silu_f(float v) { return v * __builtin_amdgcn_rcpf(1.0f + __builtin_amdgcn_exp2f(-1.4426950408889634f * v)); }
__device__ __forceinline__ u32x4 pack8bf(const f32x4& a, const f32x4& b) { u32x4 w; w.x = cvt_pk_bf16(a[0], a[1]); w.y = cvt_pk_bf16(a[2], a[3]); w.z = cvt_pk_bf16(b[0], b[1]); w.w = cvt_pk_bf16(b[2], b[3]); return w; }

enum { EM_PLAIN = 0, EM_SILU = 1, EM_ROPE = 2 };
template <int MODE>
__device__ __forceinline__ void epi_rows(const f32x4 (&acc)[2][2][4][2], int bj, bf16_t* dst, int pitch, int row0, int fq, float scale_unused, const f32x2* rope_m0  ) {
#pragma unroll
    for (int ai = 0; ai < 2; ++ai)
#pragma unroll
        for (int m = 0; m < 4; ++m) {
            const int row = row0 + ai * HALF + m * 16;
            f32x4 v0 = acc[ai][bj][m][0], v1 = acc[ai][bj][m][1];
            if (MODE == EM_SILU) {
#pragma unroll
                for (int e = 0; e < 4; ++e) { v0[e] = silu_f(v0[e]); v1[e] = silu_f(v1[e]); }
            }
            if (MODE == EM_ROPE) {
                const f32x2* cs = rope_m0 + (row & 4095) * 32;
                const f32x2 c0_ = cs[0], c1_ = cs[1], c2_ = cs[2], c3_ = cs[3];
                f32x4 r0, r1;
                r0[0] = v0[0] * c0_.x - v0[1] * c0_.y; r0[1] = v0[1] * c0_.x + v0[0] * c0_.y;
                r0[2] = v0[2] * c1_.x - v0[3] * c1_.y; r0[3] = v0[3] * c1_.x + v0[2] * c1_.y;
                r1[0] = v1[0] * c2_.x - v1[1] * c2_.y; r1[1] = v1[1] * c2_.x + v1[0] * c2_.y;
                r1[2] = v1[2] * c3_.x - v1[3] * c3_.y; r1[3] = v1[3] * c3_.x + v1[2] * c3_.y;
                v0 = r0; v1 = r1;
            }
            *(u32x4*)(dst + (size_t)row * pitch + 8 * fq) = pack8bf(v0, v1);
        }
}
template <int NBJ>
__device__ __forceinline__ void epi_ss(const f32x4 (&acc)[2][2][4][2], float* ss, int stride, int slot, int row0, int fq) {
#pragma unroll
    for (int ai = 0; ai < 2; ++ai)
#pragma unroll
        for (int m = 0; m < 4; ++m) {
            float s = 0.f;
#pragma unroll
            for (int bj = 0; bj < NBJ; ++bj) { const f32x4 v0 = acc[ai][bj][m][0], v1 = acc[ai][bj][m][1];
                s += (v0[0] * v0[0] + v0[1] * v0[1]) + (v0[2] * v0[2] + v0[3] * v0[3]) + (v1[0] * v1[0] + v1[1] * v1[1]) + (v1[2] * v1[2] + v1[3] * v1[3]); }
            s += __shfl_xor(s, 16); s += __shfl_xor(s, 32);
            if (fq == 0) ss[(size_t)(row0 + ai * HALF + m * 16) * stride + slot] = s;
        }
}
struct EpiIn {
    static constexpr bool PERM = true, AFTER_DRAIN = false;
    unsigned char* ws;
    __device__ __forceinline__ void operator()(const f32x4 (&acc)[2][2][4][2], const Unit& u, int wr, int wc, int fr, int fq) const {
        const int pn = u.pn;
        const int row0 = u.pm * BM + wr * 64 + fr;
        const int cw = wc * 32;
        if (pn >= 26) {
            bf16_t* d = (bf16_t*)(ws + OFF_MIXED) + (pn - 26) * 256 + cw;
            epi_rows<EM_SILU>(acc, 0, d, 2048, row0, fq, 0.f, nullptr); epi_rows<EM_SILU>(acc, 1, d + HALF, 2048, row0, fq, 0.f, nullptr);
        } else if (pn >= 8) {
            bf16_t* d = (bf16_t*)(ws + OFF_QKV) + (size_t)((pn - 8) >> 1) * (16384 * 512) + ((pn - 8) & 1) * 256 + cw;
            epi_rows<EM_PLAIN>(acc, 0, d, 512, row0, fq, 0.f, nullptr); epi_rows<EM_PLAIN>(acc, 1, d + HALF, 512, row0, fq, 0.f, nullptr);
        } else if (pn >= 4) {
            bf16_t* d = (bf16_t*)(ws + OFF_IDXQ) + (pn - 4) * 256 + cw;
            epi_rows<EM_PLAIN>(acc, 0, d, 1024, row0, fq, 0.f, nullptr); epi_rows<EM_PLAIN>(acc, 1, d + HALF, 1024, row0, fq, 0.f, nullptr);
        } else if (pn == 0) {
            bf16_t* d = (bf16_t*)(ws + OFF_CKV) + cw;
            epi_rows<EM_PLAIN>(acc, 0, d, 256, row0, fq, 0.f, nullptr); epi_rows<EM_PLAIN>(acc, 1, d + HALF, 256, row0, fq, 0.f, nullptr);
            epi_ss<2>(acc, (float*)(ws + OFF_SSKV), 4, wc, row0, fq);
        } else if (pn == 1) {
            bf16_t* d = (bf16_t*)(ws + OFF_CQ) + cw;
            epi_rows<EM_PLAIN>(acc, 0, d, 384, row0, fq, 0.f, nullptr); epi_rows<EM_PLAIN>(acc, 1, d + HALF, 384, row0, fq, 0.f, nullptr);
            epi_ss<2>(acc, (float*)(ws + OFF_SSQ), 8, wc, row0, fq);
        } else if (pn == 2) {
            epi_rows<EM_PLAIN>(acc, 0, (bf16_t*)(ws + OFF_CQ) + 256 + cw, 384, row0, fq, 0.f, nullptr);
            epi_ss<1>(acc, (float*)(ws + OFF_SSQ), 8, 4 + wc, row0, fq);
            if (wc < 2) epi_rows<EM_ROPE>(acc, 1, (bf16_t*)(ws + OFF_KR) + cw, 64, row0, fq, 0.f, (const f32x2*)(ws + OFF_ROPE) + 16 * wc + 4 * fq);
            else        epi_rows<EM_PLAIN>(acc, 1, (bf16_t*)(ws + OFF_IDXK) + (cw - 64), 64, row0, fq, 0.f, nullptr);
        } else {
            if (wc == 0 && fq < 2) {
                float* d = (float*)(ws + OFF_IDXW) + 8 * fq;
#pragma unroll
                for (int ai = 0; ai < 2; ++ai)
#pragma unroll
                    for (int m = 0; m < 4; ++m) { float* p = d + (size_t)(row0 + ai * HALF + m * 16) * 16; *(f32x4*)p = acc[ai][0][m][0] * 0.03125f; *(f32x4*)(p + 4) = acc[ai][0][m][1] * 0.03125f; }
            }
        }
    }
};

struct EpiTail {
    static constexpr bool PERM = true, AFTER_DRAIN = false;
    unsigned char* ws;
    __device__ __forceinline__ void operator()(const f32x4 (&acc)[2][2][4][2], const Unit& u, int wr, int wc, int fr, int fq) const {
        const int row0 = u.pm * BM + u.hs * HALF + wr * 64 + fr;
        bf16_t* d = (bf16_t*)(ws + OFF_MIXED) + (u.pn - 26) * 256 + wc * 32;
#pragma unroll
        for (int bj = 0; bj < 2; ++bj)
#pragma unroll
            for (int m = 0; m < 4; ++m) {
                f32x4 v0 = acc[0][bj][m][0], v1 = acc[0][bj][m][1];
#pragma unroll
                for (int e = 0; e < 4; ++e) { v0[e] = silu_f(v0[e]); v1[e] = silu_f(v1[e]); }
                *(u32x4*)(d + bj * HALF + (size_t)(row0 + m * 16) * 2048 + 8 * fq) = pack8bf(v0, v1);
            }
    }
};

struct EpiQ {
    static constexpr bool PERM = true, AFTER_DRAIN = false;
    unsigned char* ws;
    __device__ __forceinline__ void operator()(const f32x4 (&acc)[2][2][4][2], const Unit& u, int wr, int wc, int fr, int fq) const {
        bf16_t* const QA = (bf16_t*)(ws + OFF_QA); const float* const SSQ = (const float*)(ws + OFF_SSQ);
        const int row0 = u.pm * BM + wr * 64 + fr;
        const int cb0 = u.pn * BM + wc * 32, cb1 = cb0 + HALF;
        const int ib0 = cb0 % 192, ib1 = cb1 % 192;
        const bool rp0 = ib0 >= 128, rp1 = ib1 >= 128;
        const f32x2* const rt0 = (const f32x2*)(ws + OFF_ROPE) + ((ib0 - 128) >> 1) + 4 * fq;
        const f32x2* const rt1 = (const f32x2*)(ws + OFF_ROPE) + ((ib1 - 128) >> 1) + 4 * fq;
#pragma unroll
        for (int ai = 0; ai < 2; ++ai)
#pragma unroll
            for (int m = 0; m < 4; ++m) {
                const int row = row0 + ai * HALF + m * 16;
                const f32x4 sa = *(const f32x4*)(SSQ + (size_t)row * 8), sb = *(const f32x4*)(SSQ + (size_t)row * 8 + 4);
                const float rs = __builtin_amdgcn_rsqf((((sa[0] + sa[1]) + (sa[2] + sa[3])) + ((sb[0] + sb[1]) + (sb[2] + sb[3]))) * (1.0f / 384.0f) + 1e-6f);
#pragma unroll
                for (int bj = 0; bj < 2; ++bj) {
                    f32x4 v0 = acc[ai][bj][m][0] * rs, v1 = acc[ai][bj][m][1] * rs;
                    if (bj == 0 ? rp0 : rp1) {
                        const f32x2* cs = (bj == 0 ? rt0 : rt1) + (row & 4095) * 32;
                        const f32x2 c0_ = cs[0], c1_ = cs[1], c2_ = cs[2], c3_ = cs[3];
                        f32x4 r0, r1;
                        r0[0] = v0[0] * c0_.x - v0[1] * c0_.y; r0[1] = v0[1] * c0_.x + v0[0] * c0_.y;
                        r0[2] = v0[2] * c1_.x - v0[3] * c1_.y; r0[3] = v0[3] * c1_.x + v0[2] * c1_.y;
                        r1[0] = v1[0] * c2_.x - v1[1] * c2_.y; r1[1] = v1[1] * c2_.x + v1[0] * c2_.y;
                        r1[2] = v1[2] * c3_.x - v1[3] * c3_.y; r1[3] = v1[3] * c3_.x + v1[2] * c3_.y;
                        v0 = r0; v1 = r1;
                    }
                    *(u32x4*)(QA + (size_t)row * 768 + (bj == 0 ? cb0 : cb1) + 8 * fq) = pack8bf(v0, v1);
                }
            }
    }
};
struct EpiKV {
    static constexpr bool PERM = true, AFTER_DRAIN = false;
    unsigned char* ws;
    __device__ __forceinline__ void operator()(const f32x4 (&acc)[2][2][4][2], const Unit& u, int wr, int wc, int fr, int fq) const {
        bf16_t* const KVA = (bf16_t*)(ws + OFF_KVA); const float* const SSKV = (const float*)(ws + OFF_SSKV);
        const int row0 = u.pm * BM + wr * 64 + fr;
#pragma unroll
        for (int ai = 0; ai < 2; ++ai)
#pragma unroll
            for (int m = 0; m < 4; ++m) {
                const int row = row0 + ai * HALF + m * 16;
                const f32x4 sa = *(const f32x4*)(SSKV + (size_t)row * 4);
                const float rs = __builtin_amdgcn_rsqf(((sa[0] + sa[1]) + (sa[2] + sa[3])) * (1.0f / 256.0f) + 1e-6f);
#pragma unroll
                for (int bj = 0; bj < 2; ++bj) {
                    const int c0 = u.pn * BM + bj * HALF + wc * 32 + 8 * fq;
                    *(u32x4*)(KVA + (size_t)row * 1024 + c0) = pack8bf(acc[ai][bj][m][0] * rs, acc[ai][bj][m][1] * rs);
                }
            }
    }
};
struct EpiY {
    static constexpr bool PERM = true, AFTER_DRAIN = false;
    unsigned char* ws;
    __device__ __forceinline__ void operator()(const f32x4 (&acc)[2][2][4][2], const Unit& u, int wr, int wc, int fr, int fq) const {
        bf16_t* d = (bf16_t*)(ws + OFF_Y) + u.pn * BM + wc * 32;
        const int row0 = u.pm * BM + wr * 64 + fr;
        epi_rows<EM_PLAIN>(acc, 0, d, 2048, row0, fq, 0.f, nullptr); epi_rows<EM_PLAIN>(acc, 1, d + HALF, 2048, row0, fq, 0.f, nullptr);
    }
};
template <class Epi, class Sched, bool ALIGN_EPI = false, bool SP2 = false, bool HALFM = false>
__device__ __forceinline__ void gemm_phase(PG8_LAS unsigned char* lds, const Gemm g, const Sched& S, const Epi& E, int wave_in  ) {
    int tid_ = wave_in * 64 + fresh_lane(); asm volatile("" : "+v"(tid_));
    const int tid = tid_, wid = __builtin_amdgcn_readfirstlane(tid >> 6), lane = tid & 63, wr = wid >> 2, wc = wid & 3, fr = lane & 15, fq = lane >> 4;
    int K_ = g.K; asm volatile("" : "+s"(K_));
    const int K = K_, nt = K / BK;
    unsigned voffA[2], voffB[2];
#pragma unroll
    for (int i = 0; i < 2; ++i) { int R, C; stage_rc(tid * 16 + i * 8192, R, C); const int Rb = Epi::PERM ? ((R & ~31) + perm32(R & 31)) : R;
        voffA[i] = (unsigned)(R * K + C) * 2u; voffB[i] = (unsigned)(Rb * K + C) * 2u; }
    const size_t kstep = (size_t)(BK * 2);
    const size_t hstep = (size_t)HALF * K * 2;
    const size_t tstep = 2 * hstep;
    const size_t hstepA = HALFM ? (size_t)0 : hstep;
    static_assert(!HALFM || SP2, "HALFM needs the SP2 loop");
    const unsigned ldsw = (unsigned)wid * 1024u;
    const int aoff = lds_byte(wr * 64 + fr, fq * 8), boff = lds_byte(wc * 32 + fr, fq * 8);
#define PG8_SA(b, h) (((b) * 2 + (h)) * HTB)
#define PG8_SB(b, h) ((4 + (b) * 2 + (h)) * HTB)
#define PG8_STAGE(bufoff, gbase, voff) do { _Pragma("unroll") for (int _i = 0; _i < 2; ++_i) \
        __builtin_amdgcn_global_load_lds((const unsigned*)((const char*)(gbase) + (voff)[_i]), (PG8_LAS unsigned*)(lds + (bufoff) + ldsw + _i * 8192), 16, 0, 0); } while (0)
#define PG8_LDA(dst, b, h) do { _Pragma("unroll") for (int m = 0; m < 4; ++m) _Pragma("unroll") for (int k = 0; k < 2; ++k) dst[m][k] = *(const PG8_LAS bf16x8*)(lds + PG8_SA(b, h) + aoff + m * 2048 + k * 1024); } while (0)
#define PG8_LDB(dst, b, h) do { _Pragma("unroll") for (int n = 0; n < 2; ++n) _Pragma("unroll") for (int k = 0; k < 2; ++k) dst[n][k] = *(const PG8_LAS bf16x8*)(lds + PG8_SB(b, h) + boff + n * 2048 + k * 1024); } while (0)
#define PG8_MMA(ai, bj, At, Bt) do { __builtin_amdgcn_s_setprio(1); _Pragma("unroll") for (int m = 0; m < 4; ++m) _Pragma("unroll") for (int n = 0; n < 2; ++n) _Pragma("unroll") for (int k = 0; k < 2; ++k) \
        acc[ai][bj][m][n] = __builtin_amdgcn_mfma_f32_16x16x32_bf16(Bt[n][k], At[m][k], acc[ai][bj][m][n], 0, 0, 0); __builtin_amdgcn_s_setprio(0); } while (0)
#define PG8_WAIT_V(n) asm volatile("s_waitcnt vmcnt(" #n ")" ::: "memory")
#define PG8_WAIT_L(n) asm volatile("s_waitcnt lgkmcnt(" #n ")" ::: "memory")
#define PG8_BAR __builtin_amdgcn_s_barrier()
#define PG8_SCHED __builtin_amdgcn_sched_barrier(0)
    Unit cur, nxt; int ui = 0;
    if (!S.next(0, cur)) return;
    f32x4 acc[2][2][4][2];
#pragma unroll
    for (int a = 0; a < 2; ++a)
#pragma unroll
        for (int b = 0; b < 2; ++b)
#pragma unroll
            for (int m = 0; m < 4; ++m)
#pragma unroll
                for (int n = 0; n < 2; ++n) acc[a][b][m][n] = (f32x4){0.f, 0.f, 0.f, 0.f};
    bf16x8 At[4][2], B0[2][2], B1[2][2];
    const char* cA = (const char*)g.A + (size_t)cur.pm * tstep + (HALFM ? (size_t)cur.hs * hstep : (size_t)0); const char* cB = (const char*)g.Bt + (size_t)cur.pn * tstep;
    S.a_ready(cur);
    if constexpr (SP2) {
        PG8_STAGE(PG8_SB(0, 0), cB, voffB); PG8_STAGE(PG8_SB(0, 1), cB + hstep, voffB); PG8_STAGE(PG8_SA(0, 0), cA, voffA); PG8_STAGE(PG8_SA(0, 1), cA + hstepA, voffA);
        if (wr == 1) PG8_BAR;
        PG8_WAIT_V(2); PG8_BAR;
        PG8_STAGE(PG8_SB(1, 0), cB + kstep, voffB); PG8_STAGE(PG8_SA(1, 0), cA + kstep, voffA); PG8_STAGE(PG8_SB(1, 1), cB + hstep + kstep, voffB);
        PG8_WAIT_V(6); PG8_BAR;
    } else {
        PG8_STAGE(PG8_SB(0, 0), cB, voffB); PG8_STAGE(PG8_SA(0, 0), cA, voffA); PG8_STAGE(PG8_SB(0, 1), cB + hstep, voffB); PG8_STAGE(PG8_SA(0, 1), cA + hstep, voffA);
        if (wr == 1) PG8_BAR;
        PG8_WAIT_V(4); PG8_BAR;
        PG8_STAGE(PG8_SB(1, 0), cB + kstep, voffB); PG8_STAGE(PG8_SA(1, 0), cA + kstep, voffA); PG8_STAGE(PG8_SB(1, 1), cB + hstep + kstep, voffB);
        PG8_WAIT_V(6); PG8_BAR;
    }
    for (;;) {
        const bool has_next = S.next(ui + 1, nxt);
        const char* nA = has_next ? (const char*)g.A + (size_t)nxt.pm * tstep + (HALFM ? (size_t)nxt.hs * hstep : (size_t)0) : cA; const char* nB = has_next ? (const char*)g.Bt + (size_t)nxt.pn * tstep : cB;
        for (int t = 0; t < nt; t += 2) {
            const bool last = (t == nt - 2);
            const char* a1 = cA + (size_t)(t + 1) * kstep;
            const char* a2 = last ? nA : cA + (size_t)(t + 2) * kstep; const char* b2 = last ? nB : cB + (size_t)(t + 2) * kstep;
            const char* a3 = a2 + kstep; const char* b3 = b2 + kstep;
            if (last && has_next) S.a_ready(nxt);
            if constexpr (SP2) {
            PG8_LDB(B0, 0, 0); PG8_LDB(B1, 0, 1); PG8_SCHED; PG8_LDA(At, 0, 0); PG8_STAGE(PG8_SA(1, 1), a1 + hstepA, voffA);
            PG8_WAIT_V(8); PG8_WAIT_L(0); PG8_BAR; PG8_MMA(0, 0, At, B0); PG8_MMA(0, 1, At, B1); PG8_BAR; PG8_SCHED;
            if constexpr (!HALFM) PG8_LDA(At, 0, 1); PG8_STAGE(PG8_SB(0, 0), b2, voffB); PG8_STAGE(PG8_SB(0, 1), b2 + hstep, voffB); PG8_STAGE(PG8_SA(0, 0), a2, voffA);
            PG8_WAIT_V(8); PG8_WAIT_L(0); PG8_BAR; if constexpr (!HALFM) { PG8_MMA(1, 0, At, B0); PG8_MMA(1, 1, At, B1); } PG8_BAR; PG8_SCHED;
            PG8_LDB(B0, 1, 0); PG8_LDB(B1, 1, 1); PG8_SCHED; PG8_LDA(At, 1, 0); PG8_STAGE(PG8_SA(0, 1), a2 + hstepA, voffA);
            PG8_WAIT_V(8); PG8_WAIT_L(0); PG8_BAR; PG8_MMA(0, 0, At, B0); PG8_MMA(0, 1, At, B1); PG8_BAR; PG8_SCHED;
            if constexpr (!HALFM) PG8_LDA(At, 1, 1); PG8_STAGE(PG8_SB(1, 0), b3, voffB); PG8_STAGE(PG8_SB(1, 1), b3 + hstep, voffB); PG8_STAGE(PG8_SA(1, 0), a3, voffA);
            PG8_WAIT_V(8); PG8_WAIT_L(0); PG8_BAR; if constexpr (!HALFM) { PG8_MMA(1, 0, At, B0); PG8_MMA(1, 1, At, B1); } PG8_BAR; PG8_SCHED;
            } else {
            PG8_LDB(B0, 0, 0); PG8_SCHED; PG8_LDA(At, 0, 0); PG8_STAGE(PG8_SA(1, 1), a1 + hstep, voffA);
            PG8_WAIT_L(8); PG8_BAR; PG8_WAIT_L(0); PG8_MMA(0, 0, At, B0); PG8_BAR; PG8_SCHED;
            PG8_LDB(B1, 0, 1); PG8_STAGE(PG8_SB(0, 0), b2, voffB);
            PG8_BAR; PG8_WAIT_L(0); PG8_MMA(0, 1, At, B1); PG8_BAR;
            PG8_LDA(At, 0, 1); PG8_STAGE(PG8_SA(0, 0), a2, voffA);
            PG8_BAR; PG8_WAIT_L(0); PG8_MMA(1, 0, At, B0); PG8_BAR; PG8_SCHED;
            PG8_STAGE(PG8_SB(0, 1), b2 + hstep, voffB);
            PG8_WAIT_V(6); PG8_BAR; PG8_MMA(1, 1, At, B1); PG8_BAR;
            PG8_LDB(B0, 1, 0); PG8_SCHED; PG8_LDA(At, 1, 0); PG8_STAGE(PG8_SA(0, 1), a2 + hstep, voffA);
            PG8_WAIT_L(8); PG8_BAR; PG8_WAIT_L(0); PG8_MMA(0, 0, At, B0); PG8_BAR; PG8_SCHED;
            PG8_LDB(B1, 1, 1); PG8_STAGE(PG8_SB(1, 0), b3, voffB);
            PG8_BAR; PG8_WAIT_L(0); PG8_MMA(0, 1, At, B1); PG8_BAR;
            PG8_LDA(At, 1, 1); PG8_STAGE(PG8_SA(1, 0), a3, voffA);
            PG8_BAR; PG8_WAIT_L(0); PG8_MMA(1, 0, At, B0); PG8_BAR; PG8_SCHED;
            PG8_STAGE(PG8_SB(1, 1), b3 + hstep, voffB);
            PG8_WAIT_V(6); PG8_BAR; PG8_MMA(1, 1, At, B1); PG8_BAR;
            }
        }
        if constexpr (ALIGN_EPI) { if (wr == 0) PG8_BAR; }
        if constexpr (!Epi::AFTER_DRAIN) { E(acc, cur, wr, wc, fr, fq); S.done(cur); }
        if (!has_next) break;
#pragma unroll
        for (int a = 0; a < 2; ++a)
#pragma unroll
            for (int b = 0; b < 2; ++b)
#pragma unroll
                for (int m = 0; m < 4; ++m)
#pragma unroll
                    for (int n = 0; n < 2; ++n) acc[a][b][m][n] = (f32x4){0.f, 0.f, 0.f, 0.f};
        cur = nxt; cA = nA; cB = nB; ++ui;
        if constexpr (ALIGN_EPI) { if (wr == 1) PG8_BAR; }
    }
    PG8_WAIT_V(0);
    if constexpr (!ALIGN_EPI) { if (wr == 0) PG8_BAR; }
    PG8_BAR;
    if constexpr (Epi::AFTER_DRAIN) { E.fused(acc, cur, wr, wc, fr, fq, lds, wid, lane); S.done(cur); }
#undef PG8_SA
#undef PG8_SB
#undef PG8_STAGE
#undef PG8_LDA
#undef PG8_LDB
#undef PG8_MMA
#undef PG8_WAIT_V
#undef PG8_WAIT_L
#undef PG8_BAR
#undef PG8_SCHED
}
}
#define XB_TMO      128
#define XB_XCNT(j)  (256  + 64 * (j))
#define XB_XSUB(j)  (1280 + 64 * (j))
#define XB_XGEN(j)  (2304 + 64 * (j))
#define XB_TOP      3328
#define XB_TOPGEN   3392
#define XCD_BAR_WORDS 3456
#define XB_SPIN_CAP (1u << 18)
#define LAS __attribute__((address_space(3)))

__device__ __forceinline__ unsigned xb_ld(unsigned* p)              { return __hip_atomic_load(p, __ATOMIC_RELAXED, __HIP_MEMORY_SCOPE_AGENT); }
__device__ __forceinline__ unsigned xb_add(unsigned* p, unsigned v) { return __hip_atomic_fetch_add(p, v, __ATOMIC_RELAXED, __HIP_MEMORY_SCOPE_AGENT); }
__device__ __forceinline__ unsigned xb_xcc_id() { return (unsigned)__builtin_amdgcn_s_getreg((3 << 11) | 20) & 0xFu; }
#define XB_SPIN(cond, bar) do { unsigned _sp = 0; while (cond) { __builtin_amdgcn_s_sleep(1); \
    if ((++_sp & 255u) == 0u) { if (xb_ld(&(bar)[XB_TMO])) break; if (_sp > XB_SPIN_CAP) { atomicAdd(&(bar)[XB_TMO], 1u); break; } } } } while (0)

struct XcdBarrier {
    int wave0;
    unsigned* bar; unsigned x;
    volatile LAS unsigned* st;
};

__device__ __forceinline__ XcdBarrier xcd_barrier_post(unsigned* bar, volatile LAS unsigned* st) {
    XcdBarrier b; b.bar = bar; b.x = xb_xcc_id(); b.st = st;
    if (threadIdx.x == 0) (void)xb_add(&bar[XB_XCNT(b.x)], 1u);
    return b;
}
__device__ __forceinline__ void xcd_barrier_complete(unsigned* bar, unsigned x, unsigned& nloc, unsigned& nx) {
    const unsigned G = gridDim.x * gridDim.y * gridDim.z;
    unsigned sum, cnt, mine, sp = 0u;
    for (;;) {
        sum = 0u; cnt = 0u; mine = 0u;
#pragma unroll
        for (unsigned j = 0; j < 16; ++j) { const unsigned c = xb_ld(&bar[XB_XCNT(j)]); sum += c; cnt += (c > 0u) ? 1u : 0u; mine = (j == x) ? c : mine; }
        if (sum == G) break;
        __builtin_amdgcn_s_sleep(1);
        if ((++sp & 255u) == 0u) { if (xb_ld(&bar[XB_TMO])) break; if (sp > XB_SPIN_CAP) { atomicAdd(&bar[XB_TMO], 1u); break; } }
    }
    nloc = mine > 0u ? mine : 1u; nx = cnt > 0u ? cnt : 1u;
}

__device__ __forceinline__ void xcd_barrier(const XcdBarrier& b) {
    asm volatile("s_waitcnt vmcnt(0)" ::: "memory");
    __syncthreads();
    if (b.wave0 == 0 && fresh_lane() == 0) {
        unsigned* bar = b.bar;
        __builtin_amdgcn_s_waitcnt(0);
        unsigned nloc = b.st[0], nx = b.st[1];
        if (nloc == 0u) { xcd_barrier_complete(bar, b.x, nloc, nx); b.st[0] = nloc; b.st[1] = nx; }
        const unsigned old = xb_add(&bar[XB_XSUB(b.x)], 1u);
        const unsigned gen = old / nloc;
        if (old + 1u == (gen + 1u) * nloc) {
            __builtin_amdgcn_fence(__ATOMIC_RELEASE, "agent");
            asm volatile("s_waitcnt vmcnt(0)" ::: "memory");
            const unsigned og = xb_add(&bar[XB_TOP], 1u);
            const unsigned tg = og / nx;
            if (og + 1u == (tg + 1u) * nx) xb_add(&bar[XB_TOPGEN], 1u);
            else XB_SPIN(xb_ld(&bar[XB_TOPGEN]) == tg, bar);
            __builtin_amdgcn_fence(__ATOMIC_ACQUIRE, "agent");
            xb_add(&bar[XB_XGEN(b.x)], 1u);
            asm volatile("s_waitcnt vmcnt(0)" ::: "memory");
        } else {
            XB_SPIN(xb_ld(&bar[XB_XGEN(b.x)]) == gen, bar);
            __builtin_amdgcn_fence(__ATOMIC_ACQUIRE, "agent");
            asm volatile("s_waitcnt vmcnt(0)" ::: "memory");
        }
    }
    __syncthreads();
}

using pg8::bf16_t; using pg8::f32x4; using pg8::u32x4; using pg8::f32x2;
constexpr int SEQ = 4096, DM = 2048, INW = 8464;
constexpr float LOG2E = 1.4426950408889634f;
constexpr int NWAVES = 8;
constexpr int LDS_BYTES = 147456, MISC_OFF = LDS_BYTES - 256;
constexpr int N_PHASES = 12;

__constant__ float ROPE_INV[32] = {1.000000000e+00f, 7.498942614e-01f, 5.623413324e-01f, 4.216965139e-01f, 3.162277639e-01f, 2.371373773e-01f, 1.778279394e-01f, 1.333521307e-01f,
    1.000000015e-01f, 7.498941571e-02f, 5.623413250e-02f, 4.216965288e-02f, 3.162277490e-02f, 2.371373773e-02f, 1.778279431e-02f, 1.333521493e-02f,
    9.999999776e-03f, 7.498941850e-03f, 5.623413250e-03f, 4.216964822e-03f, 3.162277630e-03f, 2.371373586e-03f, 1.778279431e-03f, 1.333521446e-03f,
    1.000000047e-03f, 7.498942432e-04f, 5.623413017e-04f, 4.216965172e-04f, 3.162277571e-04f, 2.371373703e-04f, 1.778279402e-04f, 1.333521504e-04f};

struct Args { const float* in[18]; float* out; unsigned char* ws; int ph_lo, ph_hi; };
struct Frame {
    LAS unsigned char* lds; int wave, G, vcu;
    const Args* a; float* out; unsigned char* ws;
};
#define FIN(i) (F.a->in[i])
#define WSP(T, off) ((T*)(ws_l + (off)))
#define WS_LOCAL size_t wz_ = 0; int bid = (int)blockIdx.x, G_l = F.G; asm volatile("" : "+s"(wz_), "+s"(bid), "+s"(G_l)); unsigned char* const ws_l = F.ws + wz_; (void)bid; (void)G_l;
#define PHASE_LOCALS int lane_ = fresh_lane(); asm volatile("" : "+v"(lane_)); const int lane = lane_, wave = F.wave, tid = wave * 64 + lane; (void)tid; WS_LOCAL

__device__ __forceinline__ float bf_lo(unsigned w) { return __uint_as_float(w << 16); }
__device__ __forceinline__ float bf_hi(unsigned w) { return __uint_as_float(w & 0xffff0000u); }
__device__ __forceinline__ float wave_max(float v) { for (int o = 32; o; o >>= 1) v = fmaxf(v, __shfl_xor(v, o)); return v; }
__device__ __forceinline__ float wave_sum(float v) { for (int o = 32; o; o >>= 1) v += __shfl_xor(v, o); return v; }
#define LDS_WAVE_SYNC() asm volatile("s_waitcnt lgkmcnt(0)" ::: "memory")

__device__ __forceinline__ int t5_bucket(int n) {
    if (n < 16) return n;
    int b = 16;
    b += (n >= 22) + (n >= 30) + (n >= 40) + (n >= 54) + (n >= 73) + (n >= 99) + (n >= 134) + (n >= 182) + (n >= 246) + (n >= 332) + (n >= 450) + (n >= 609) + (n >= 825) + (n >= 1117) + (n >= 1513);
    return b;
}
__device__ __forceinline__ int src_in(int n) {
    if (n < 256) return 384 + n;
    if (n < 512) return n - 256;
    if (n < 640) return n - 256;
    if (n < 704) { const int t = n - 640; return 640 + ((t & 1) ? 32 + (t >> 1) : (t >> 1)); }
    if (n < 768) return 4800 + (n - 704);
    if (n < 784) return 4864 + (n - 768);
    if (n < 1024) return -1;
    if (n < 2048) return 3776 + (n - 1024);
    if (n < 3584) return 704 + (n - 2048);
    if (n < 5120) return 2240 + (n - 3584);
    if (n < 6656) return 4880 + (n - 5120);
    return 6416 + (n - 6656);
}
__device__ __forceinline__ int src_uq(int n) { const int h = n / 192, i = n % 192; if (i < 128) return n; const int t = i - 128; return h * 192 + 128 + ((t & 1) ? 32 + (t >> 1) : (t >> 1)); }

struct Src8 { int ia, ib, kind; };
__device__ __forceinline__ Src8 src8_of(int mat, int n0) {
    Src8 r; int c0 = n0; r.kind = 0;
    if (mat == 0) { if (n0 >= 640 && n0 < 704) { r.kind = 1; c0 = 640 + ((n0 - 640) >> 1); } else c0 = src_in(n0); }
    else if (mat == 2) { const int h = n0 / 192, i0 = n0 % 192; if (i0 >= 128) { r.kind = 1; c0 = h * 192 + 128 + ((i0 - 128) >> 1); } }
    if (c0 < 0) { r.kind = 2; c0 = 0; }
    r.ia = c0; r.ib = (r.kind == 1) ? c0 + 32 : c0 + 4;
    return r;
}
__device__ __forceinline__ void combine8(const Src8& s, const f32x4& a, const f32x4& b, float gk, float (&o)[8]) {
    if (s.kind == 1) { o[0] = a[0]; o[1] = b[0]; o[2] = a[1]; o[3] = b[1]; o[4] = a[2]; o[5] = b[2]; o[6] = a[3]; o[7] = b[3]; }
    else { o[0] = a[0]; o[1] = a[1]; o[2] = a[2]; o[3] = a[3]; o[4] = b[0]; o[5] = b[1]; o[6] = b[2]; o[7] = b[3]; }
#pragma unroll
    for (int e = 0; e < 8; ++e) o[e] = (s.kind == 2) ? 0.f : o[e] * gk;
}
struct WTile { int mat, nt, kt, K, ldsrc; const float* src; bf16_t* dst; const float* gain; };
__device__ __forceinline__ WTile wtile_of(const Frame& F, unsigned char* ws_l, int l, int v) {
    constexpr int U_IN = 136 * 32, U_OUT = 32 * 32, U_UQ = 12 * 6;
    WTile t; t.gain = nullptr;
    if (v < U_IN) { t.mat = 0; t.nt = v % 136; t.kt = v / 136; t.K = 2048; t.ldsrc = INW; t.src = FIN(6) + (size_t)l * 2048 * INW; t.dst = WSP(bf16_t, l == 0 ? WS_WTIN0 : WS_WTIN1); }
    else if ((v -= U_IN) < U_OUT) { t.mat = 1; t.nt = v & 31; t.kt = v >> 5; t.K = 2048; t.ldsrc = 2048; t.src = FIN(16) + (size_t)l * 2048 * 2048; t.dst = WSP(bf16_t, WS_WTOUT) + (size_t)l * 2048 * 2048; }
    else if ((v -= U_OUT) < U_UQ) { t.mat = 2; t.nt = v % 12; t.kt = v / 12; t.K = 384; t.ldsrc = 768; t.src = FIN(8) + (size_t)l * 384 * 768; t.dst = WSP(bf16_t, WS_WTUQ) + (size_t)l * 768 * 384; t.gain = FIN(7) + l * 384; }
    else { v -= U_UQ; t.mat = 3; t.nt = v & 15; t.kt = v >> 4; t.K = 256; t.ldsrc = 1024; t.src = FIN(10) + (size_t)l * 256 * 1024; t.dst = WSP(bf16_t, WS_WTUKV) + (size_t)l * 1024 * 256; t.gain = FIN(9) + l * 256; }
    return t;
}
__device__ __forceinline__ void convert_weights(const Frame& F, int l, int qidx) {
    PHASE_LOCALS
    LAS float* tiles = (LAS float*)F.lds;
    constexpr int U_L = 136 * 32 + 32 * 32 + 12 * 6 + 16 * 4, NB = 4, TSZ = 64 * 65;
    unsigned* qctr = (unsigned*)(ws_l + WS_CTL + 16384 + qidx * 256);
    volatile LAS unsigned* qslot = (volatile LAS unsigned*)(F.lds + MISC_OFF) + 16;
    if (tid == 0) { const unsigned q0_ = atomicAdd(qctr, (unsigned)NB), q1_ = atomicAdd(qctr, (unsigned)NB); qslot[0] = q0_; qslot[1] = q1_; }
    __syncthreads();
    int u0 = (int)qslot[0], u1 = (int)qslot[1];
    __syncthreads();
    const int k = tid >> 3, n8 = (tid & 7) * 8;
    WTile t[NB]; Src8 sd[NB]; f32x4 va[NB], vb[NB]; float gk[NB];
#define CW_LOAD(U) do { _Pragma("unroll") for (int i = 0; i < NB; ++i) { t[i] = wtile_of(F, ws_l, l, (U) + i); sd[i] = src8_of(t[i].mat, t[i].nt * 64 + n8); } \
        _Pragma("unroll") for (int i = 0; i < NB; ++i) { const float* srow = t[i].src + (size_t)(t[i].kt * 64 + k) * t[i].ldsrc; \
            va[i] = *(const f32x4*)(srow + sd[i].ia); vb[i] = *(const f32x4*)(srow + sd[i].ib); gk[i] = t[i].gain ? t[i].gain[t[i].kt * 64 + k] : 1.0f; } } while (0)
    if (u0 < U_L) CW_LOAD(u0);
    while (u0 < U_L) {
        unsigned u2 = 0u; if (tid == 0) u2 = atomicAdd(qctr, (unsigned)NB);
#pragma unroll
        for (int i = 0; i < NB; ++i) { float o[8]; combine8(sd[i], va[i], vb[i], gk[i], o);
#pragma unroll
            for (int e = 0; e < 8; ++e) tiles[i * TSZ + k * 65 + n8 + e] = o[e]; }
        bf16_t* dst[NB]; int dK[NB];
#pragma unroll
        for (int i = 0; i < NB; ++i) { dK[i] = t[i].K; dst[i] = t[i].dst + (size_t)(t[i].nt * 64) * t[i].K + t[i].kt * 64; }
        if (u1 < U_L) CW_LOAD(u1);
        __syncthreads();
        const int n = tid >> 3, k8 = (tid & 7) * 8;
#pragma unroll
        for (int i = 0; i < NB; ++i) {
            float v[8];
#pragma unroll
            for (int e = 0; e < 8; ++e) v[e] = tiles[i * TSZ + (k8 + e) * 65 + n];
            u32x4 w; w.x = pg8::cvt_pk_bf16(v[0], v[1]); w.y = pg8::cvt_pk_bf16(v[2], v[3]); w.z = pg8::cvt_pk_bf16(v[4], v[5]); w.w = pg8::cvt_pk_bf16(v[6], v[7]);
            *(u32x4*)(dst[i] + (size_t)n * dK[i] + k8) = w;
        }
        if (tid == 0) qslot[0] = u2;
        __syncthreads();
        u0 = u1; u1 = (int)qslot[0];
    }
#undef CW_LOAD
    __syncthreads();
}
__device__ __forceinline__ void p0_prologue(const Frame& F) {
    PHASE_LOCALS
    LAS float* tile = (LAS float*)F.lds;
    for (int it = bid; it < 192; it += G_l) {
        const int l = it / 96, n0 = (it % 96) * 64;
        LAS float* sc = tile;
        LAS float* part = tile + 8192;
        for (int i = tid; i < 8192; i += NWAVES * 64) sc[i] = pg8::silu_f(FIN(1)[i]);
        __syncthreads();
        const int kk = tid >> 4, c4 = (tid & 15) * 4;
        float acc[4][4];
#pragma unroll
        for (int i = 0; i < 4; ++i)
#pragma unroll
            for (int b = 0; b < 4; ++b) acc[i][b] = 0.f;
        const float* wp = FIN(2) + (size_t)l * 2048 * 6144 + n0 + c4;
#pragma unroll 8
        for (int k = kk; k < 2048; k += 32) {
            const f32x4 w = *(const f32x4*)(wp + (size_t)k * 6144);
#pragma unroll
            for (int b = 0; b < 4; ++b) { const float sv = sc[b * 2048 + k]; acc[0][b] += sv * w[0]; acc[1][b] += sv * w[1]; acc[2][b] += sv * w[2]; acc[3][b] += sv * w[3]; }
        }
#pragma unroll
        for (int i = 0; i < 4; ++i) *(LAS f32x4*)(part + (kk * 64 + c4 + i) * 4) = (f32x4){acc[i][0], acc[i][1], acc[i][2], acc[i][3]};
        __syncthreads();
        if (tid < 256) {
            const int n = tid >> 2, b = tid & 3;
            float sum = 0.f;
            for (int q = 0; q < 32; ++q) sum += part[(q * 64 + n) * 4 + b];
            WSP(float, WS_MOD)[(size_t)(l * 4 + b) * 6144 + n0 + n] = sum + FIN(3)[l * 6144 + n0 + n];
        }
        __syncthreads();
    }
    convert_weights(F, 0, 16);
    convert_weights(F, 1, 17);
    const int gt = bid * (NWAVES * 64) + tid, GT = G_l * NWAVES * 64;
    for (int i = gt; i < 4096 * 32; i += GT) {
        const int pos = i >> 5, f = i & 31;
        const float ang = (float)pos * ROPE_INV[f];
        const double x = (double)ang;
        const double q = __builtin_rint(x * 0.63661977236758134308);
        double r = __builtin_fma(-q, 1.57079632679489655800e+00, x); r = __builtin_fma(-q, 6.12323399573676603587e-17, r);
        const double r2 = r * r;
        const double sn = r * (1.0 + r2 * (-1.0 / 6 + r2 * (1.0 / 120 + r2 * (-1.0 / 5040 + r2 * (1.0 / 362880 + r2 * (-1.0 / 39916800 + r2 * (1.0 / 6227020800.0)))))));
        const double cn = 1.0 + r2 * (-0.5 + r2 * (1.0 / 24 + r2 * (-1.0 / 720 + r2 * (1.0 / 40320 + r2 * (-1.0 / 3628800 + r2 * (1.0 / 479001600.0))))));
        const int qi = (int)q & 3;
        const double s = (qi == 0) ? sn : (qi == 1) ? cn : (qi == 2) ? -sn : -cn;
        const double c = (qi == 0) ? cn : (qi == 1) ? -sn : (qi == 2) ? -cn : sn;
        f32x2 o; o.x = (float)c; o.y = (float)s; WSP(f32x2, WS_ROPE)[i] = o;
    }
    for (int i = gt; i < 8 * 4096; i += GT) { const int hh = i >> 12, d = i & 4095; WSP(float, WS_TCD)[i] = FIN(17)[t5_bucket(d) * 12 + 4 + hh] * LOG2E; }
    for (int i = gt; i < 3 * 4 * 192; i += GT) {
        const int g = i / 768, h = (i / 192) & 3, j = i % 192;
        const int dist = (g == 0 ? 1 : g == 1 ? 4 : 16) * (j > 128 ? 128 : j);
        WSP(float, WS_TB)[i] = FIN(17)[t5_bucket(dist) * 12 + h] * LOG2E;
    }
    if (gt < 2) {
        const int l = gt; float s1 = 0.f, s2 = 0.f;
        for (int i = 0; i < 64; ++i) { s1 += FIN(11)[l * 64 + i] * FIN(12)[l * 64 + i]; s2 += FIN(13)[l * 64 + i] * FIN(14)[l * 64 + i]; }
        const float li = (l == 0) ? 0.2f : 0.35550906759096926f;
        WSP(float, WS_CONST)[l] = expf(s1) - expf(s2) + li;
    }
}

#define DPP_ADD(v, ctrl) v += __builtin_bit_cast(float, __builtin_amdgcn_update_dpp(0, __builtin_bit_cast(int, v), ctrl, 0xF, 0xF, true))
__device__ __forceinline__ float wave_sum_v(float v) {
    DPP_ADD(v, 0xB1); DPP_ADD(v, 0x4E); DPP_ADD(v, 0x141); DPP_ADD(v, 0x140);
    { auto r = __builtin_amdgcn_permlane16_swap(__float_as_uint(v), __float_as_uint(v), false, false); v = __uint_as_float(r[0]) + __uint_as_float(r[1]); }
    { auto r = __builtin_amdgcn_permlane32_swap(__float_as_uint(v), __float_as_uint(v), false, false); v = __uint_as_float(r[0]) + __uint_as_float(r[1]); }
    return v;
}
constexpr int NV_A = 0, NV_B = 2048, NV_C = 4096;
__device__ __forceinline__ void lds8(const LAS float* p, float (&o)[8]) { const f32x4 a = *(const LAS f32x4*)p, b = *(const LAS f32x4*)(p + 4); o[0] = a[0]; o[1] = a[1]; o[2] = a[2]; o[3] = a[3]; o[4] = b[0]; o[5] = b[1]; o[6] = b[2]; o[7] = b[3]; }
__device__ __forceinline__ void store_h8(bf16_t* hp, const float (&v)[8], float rs, const LAS float* vb, const LAS float* vc) {
    float B[8], C[8]; lds8(vb, B); lds8(vc, C);
    float h[8];
#pragma unroll
    for (int e = 0; e < 8; ++e) h[e] = v[e] * rs * B[e] + C[e];
    u32x4 w; w.x = pg8::cvt_pk_bf16(h[0], h[1]); w.y = pg8::cvt_pk_bf16(h[2], h[3]); w.z = pg8::cvt_pk_bf16(h[4], h[5]); w.w = pg8::cvt_pk_bf16(h[6], h[7]);
    *(u32x4*)hp = w;
}
__device__ __forceinline__ void p_pre0(const Frame& F) {
    PHASE_LOCALS
    LAS float* vec = (LAS float*)F.lds;
    const float* mod = WSP(float, WS_MOD);
    for (int t = bid; t < M / 64; t += G_l) {
        const int b = t >> 6;
        __syncthreads();
        { const float* mb = mod + (size_t)(0 * 4 + b) * 6144; const float* gp = FIN(4);
          for (int c = tid; c < 2048; c += NWAVES * 64) { vec[NV_B + c] = gp[c] * (1.0f + mb[2048 + c]); vec[NV_C + c] = mb[c]; } }
        __syncthreads();
#pragma unroll 1
        for (int rp = 0; rp < 8; ++rp) {
            const int r0 = t * 64 + wave * 8 + rp;
            float xv[1][4][8];
#pragma unroll
            for (int q = 0; q < 1; ++q)
#pragma unroll
                for (int i = 0; i < 4; ++i) { const float* xp = FIN(0) + (size_t)(r0 + q) * DM + (i * 64 + lane) * 8; const f32x4 a = *(const f32x4*)xp, c = *(const f32x4*)(xp + 4);
                    xv[q][i][0] = a[0]; xv[q][i][1] = a[1]; xv[q][i][2] = a[2]; xv[q][i][3] = a[3]; xv[q][i][4] = c[0]; xv[q][i][5] = c[1]; xv[q][i][6] = c[2]; xv[q][i][7] = c[3]; }
#pragma unroll
            for (int q = 0; q < 1; ++q) {
                float ss = 0.f;
#pragma unroll
                for (int i = 0; i < 4; ++i)
#pragma unroll
                    for (int e = 0; e < 8; ++e) ss += xv[q][i][e] * xv[q][i][e];
                ss = wave_sum_v(ss);
                const float rs = __builtin_amdgcn_rsqf(ss * (1.0f / 2048.0f) + 1e-6f);
#pragma unroll
                for (int i = 0; i < 4; ++i) { const int c = (i * 64 + lane) * 8; store_h8(WSP(bf16_t, WS_H) + (size_t)(r0 + q) * DM + c, xv[q][i], rs, vec + NV_B + c, vec + NV_C + c); }
            }
        }
    }
    __syncthreads();
}
__device__ __forceinline__ void p_post(const Frame& F, int l) {
    PHASE_LOCALS
    LAS float* vec = (LAS float*)F.lds;
    const float* mod = WSP(float, WS_MOD);
    const bf16_t* Y = WSP(bf16_t, WS_Y);
    const float* xin = (l == 0) ? FIN(0) : F.out;
    for (int t = bid; t < M / 64; t += G_l) {
        const int b = t >> 6;
        __syncthreads();
        { const float* gate = mod + (size_t)(l * 4 + b) * 6144 + 4096; const float* gpo = FIN(5) + l * DM; const float* mb1 = mod + (size_t)(1 * 4 + b) * 6144; const float* gp1 = FIN(4) + DM;
          for (int c = tid; c < 2048; c += NWAVES * 64) { vec[NV_A + c] = gate[c] * gpo[c]; if (l == 0) { vec[NV_B + c] = gp1[c] * (1.0f + mb1[2048 + c]); vec[NV_C + c] = mb1[c]; } } }
        __syncthreads();
#pragma unroll 1
        for (int rp = 0; rp < 8; ++rp) {
            const int r0 = t * 64 + wave * 8 + rp;
            u32x4 yr[1][4]; float xv[1][4][8];
#pragma unroll
            for (int q = 0; q < 1; ++q)
#pragma unroll
                for (int i = 0; i < 4; ++i) { const size_t o = (size_t)(r0 + q) * DM + (i * 64 + lane) * 8; yr[q][i] = *(const u32x4*)(Y + o);
                    if (l == 0) { const f32x4 a = *(const f32x4*)(xin + o), c = *(const f32x4*)(xin + o + 4);
                        xv[q][i][0] = a[0]; xv[q][i][1] = a[1]; xv[q][i][2] = a[2]; xv[q][i][3] = a[3]; xv[q][i][4] = c[0]; xv[q][i][5] = c[1]; xv[q][i][6] = c[2]; xv[q][i][7] = c[3]; }
                    else {
                        const u32x4 w = *(const u32x4*)((const bf16_t*)(xin + (size_t)(r0 + q) * DM) + (i * 64 + lane) * 8);
                        xv[q][i][0] = bf_lo(w.x); xv[q][i][1] = bf_hi(w.x); xv[q][i][2] = bf_lo(w.y); xv[q][i][3] = bf_hi(w.y); xv[q][i][4] = bf_lo(w.z); xv[q][i][5] = bf_hi(w.z); xv[q][i][6] = bf_lo(w.w); xv[q][i][7] = bf_hi(w.w); } }
#pragma unroll
            for (int q = 0; q < 1; ++q) {
                float yv[4][8]; float ss = 0.f;
#pragma unroll
                for (int i = 0; i < 4; ++i) { const u32x4 w = yr[q][i];
                    yv[i][0] = bf_lo(w.x); yv[i][1] = bf_hi(w.x); yv[i][2] = bf_lo(w.y); yv[i][3] = bf_hi(w.y); yv[i][4] = bf_lo(w.z); yv[i][5] = bf_hi(w.z); yv[i][6] = bf_lo(w.w); yv[i][7] = bf_hi(w.w);
#pragma unroll
                    for (int e = 0; e < 8; ++e) ss += yv[i][e] * yv[i][e]; }
                ss = wave_sum_v(ss);
                const float rs = __builtin_amdgcn_rsqf(ss * (1.0f / 2048.0f) + 1e-6f);
                float ss2 = 0.f;
#pragma unroll
                for (int i = 0; i < 4; ++i) { const int c = (i * 64 + lane) * 8; float A[8]; lds8(vec + NV_A + c, A);
#pragma unroll
                    for (int e = 0; e < 8; ++e) { const float xn = xv[q][i][e] + A[e] * (yv[i][e] * rs); xv[q][i][e] = xn; ss2 += xn * xn; }
                    float* op = F.out + (size_t)(r0 + q) * DM + c;
                    if (l == 0) { u32x4 w; w.x = pg8::cvt_pk_bf16(xv[q][i][0], xv[q][i][1]); w.y = pg8::cvt_pk_bf16(xv[q][i][2], xv[q][i][3]); w.z = pg8::cvt_pk_bf16(xv[q][i][4], xv[q][i][5]); w.w = pg8::cvt_pk_bf16(xv[q][i][6], xv[q][i][7]);
                        *(u32x4*)((bf16_t*)(F.out + (size_t)(r0 + q) * DM) + c) = w; }
                    else { *(f32x4*)op = (f32x4){xv[q][i][0], xv[q][i][1], xv[q][i][2], xv[q][i][3]}; *(f32x4*)(op + 4) = (f32x4){xv[q][i][4], xv[q][i][5], xv[q][i][6], xv[q][i][7]}; } }
                if (l == 0) {
                    ss2 = wave_sum_v(ss2);
                    const float rs2 = __builtin_amdgcn_rsqf(ss2 * (1.0f / 2048.0f) + 1e-6f);
#pragma unroll
                    for (int i = 0; i < 4; ++i) { const int c = (i * 64 + lane) * 8; store_h8(WSP(bf16_t, WS_H) + (size_t)(r0 + q) * DM + c, xv[q][i], rs2, vec + NV_B + c, vec + NV_C + c); }
                }
            }
        }
    }
    __syncthreads();
}

__device__ __forceinline__ void p_gemm1(const Frame& F, int l) {
    WS_LOCAL
    pg8::Gemm g; g.A = WSP(bf16_t, WS_H); g.Bt = WSP(bf16_t, l == 0 ? WS_WTIN0 : WS_WTIN1); g.M = M; g.N = NW1; g.K = 2048;
    const bool full_grid = (G_l == 256);
    pg8::StaticOrder S; S.init(M, full_grid ? 32 * 256 : NW1, G_l, bid);
    pg8::EpiIn E; E.ws = ws_l;
    pg8::gemm_phase<pg8::EpiIn, pg8::StaticOrder, true, true>(F.lds, g, S, E, F.wave);
    if (full_grid) {
        pg8::TailOrder T; T.c = bid;
        pg8::EpiTail ET; ET.ws = ws_l;
        pg8::gemm_phase<pg8::EpiTail, pg8::TailOrder, true, true, true>(F.lds, g, T, ET, F.wave);
    }

}
__device__ __forceinline__ void p_upq(const Frame& F, int l) {
    WS_LOCAL
    pg8::Gemm g; g.A = WSP(bf16_t, WS_CQ); g.Bt = WSP(bf16_t, WS_WTUQ) + (size_t)l * 768 * 384; g.M = M; g.N = 768; g.K = 384;
    pg8::StaticOrder S; S.init(M, 768, G_l, bid);
    pg8::EpiQ E; E.ws = ws_l;
    pg8::gemm_phase<pg8::EpiQ, pg8::StaticOrder, true, true>(F.lds, g, S, E, F.wave);
}
__device__ __forceinline__ void p_upkv(const Frame& F, int l) {
    WS_LOCAL
    pg8::Gemm g; g.A = WSP(bf16_t, WS_CKV); g.Bt = WSP(bf16_t, WS_WTUKV) + (size_t)l * 1024 * 256; g.M = M; g.N = 1024; g.K = 256;
    pg8::StaticOrder S; S.init(M, 1024, G_l, bid);
    pg8::EpiKV E; E.ws = ws_l;
    pg8::gemm_phase<pg8::EpiKV, pg8::StaticOrder, true, true>(F.lds, g, S, E, F.wave);
}
__device__ __forceinline__ void p_gemm2(const Frame& F, int l) {
    WS_LOCAL
    pg8::Gemm g; g.A = WSP(bf16_t, WS_MIXED); g.Bt = WSP(bf16_t, WS_WTOUT) + (size_t)l * 2048 * 2048; g.M = M; g.N = 2048; g.K = 2048;
    pg8::StaticOrder S; S.init(M, 2048, G_l, bid);
    pg8::EpiY E; E.ws = ws_l;
    pg8::gemm_phase<pg8::EpiY, pg8::StaticOrder, true, true>(F.lds, g, S, E, F.wave);
}

__device__ __forceinline__ unsigned score_key(float x) { const unsigned b = __float_as_uint(x); return b ^ ((unsigned)((int)b >> 31) | 0x80000000u); }
__device__ __forceinline__ int wave_sum_i(int v) { for (int o = 32; o; o >>= 1) v += __shfl_xor(v, o); return v; }
extern "C" __device__ int llvm_writelane_i32(int, int, int) __asm("llvm.amdgcn.writelane.i32");
__device__ __forceinline__ unsigned wave_max_u(unsigned v) {
#define DPP_MAXU(v, ctrl) v = max(v, (unsigned)__builtin_amdgcn_update_dpp(0, (int)v, ctrl, 0xF, 0xF, true))
    DPP_MAXU(v, 0xB1); DPP_MAXU(v, 0x4E); DPP_MAXU(v, 0x141); DPP_MAXU(v, 0x140);
#undef DPP_MAXU
    const unsigned a = (unsigned)__builtin_amdgcn_readlane((int)v, 0), b = (unsigned)__builtin_amdgcn_readlane((int)v, 16), c = (unsigned)__builtin_amdgcn_readlane((int)v, 32), d = (unsigned)__builtin_amdgcn_readlane((int)v, 48);
    return max(max(a, b), max(c, d));
}
__device__ __forceinline__ bool select_row(const unsigned (&u)[64], int qpos, unsigned long long* mrow, int lane, LAS unsigned* cbuf  ) {
    unsigned long long myw = 0ull;
    if (qpos < 256) {
        const int lo = lane * 64;
        if (lo + 63 <= qpos) myw = ~0ull; else if (lo <= qpos) myw = (~0ull) >> (63 - (qpos - lo)); else myw = 0ull;
        mrow[lane] = myw; return true;
    }
    const int nj = (qpos >> 6) + 1;
    unsigned thr = 0u; bool exact = false;
    int lo_cnt = qpos + 1, hi_cnt = 0, bit = 31, scan = 6;
    unsigned P;
    {
        unsigned mx = 0u;
#pragma unroll
        for (int g = 0; g < 8; ++g) {
            if (8 * g < nj) {
#pragma unroll
                for (int q = 0; q < 8; ++q) mx = max(mx, u[8 * g + q]);
            }
        }
        P = wave_max_u(mx) >> 23;
    }
#pragma unroll 1
    for (;;) {
        if (scan == 0) { if (bit < 0 || lo_cnt - hi_cnt <= 64) break; }
        const unsigned cand = scan ? (P << 23) : (thr | (1u << bit));
        int cnt = 0;
#pragma unroll
        for (int g = 0; g < 8; ++g) {
            if (8 * g < nj) {
                unsigned long long m8[8];
#pragma unroll
                for (int q = 0; q < 8; ++q) m8[q] = __ballot(u[8 * g + q] >= cand);
                asm volatile("" :: "s"(m8[0]), "s"(m8[1]), "s"(m8[2]), "s"(m8[3]), "s"(m8[4]), "s"(m8[5]), "s"(m8[6]), "s"(m8[7]));
#pragma unroll
                for (int q = 0; q < 8; ++q) cnt += __popcll(m8[q]);
            }
        }
        if (scan) {
            if (cnt >= 256) { thr = cand; lo_cnt = cnt; bit = 22; scan = 0; if (cnt == 256) { exact = true; break; } }
            else { hi_cnt = cnt; --P; if (--scan == 0) { hi_cnt = 0; bit = 31; } }
        } else {
            if (cnt >= 256) { thr = cand; lo_cnt = cnt; if (cnt == 256) { exact = true; break; } } else hi_cnt = cnt;
            --bit;
        }
    }
    if (!exact && bit >= 0) {
        const unsigned tlo = thr ? thr : 1u;
        const unsigned span = ((bit == 31) ? 0xFFFFFFFFu : (thr + ((2u << bit) - 1u))) - tlo;
        unsigned base = 0u;
        cbuf[lane] = 0u;
#pragma unroll
        for (int g = 0; g < 8; ++g) {
            if (8 * g < nj) {
#pragma unroll
                for (int j = 8 * g; j < 8 * g + 8; ++j) {
                    const bool inb = (u[j] - tlo) <= span;
                    const unsigned long long m = __ballot(inb);
                    if (inb) cbuf[__builtin_amdgcn_mbcnt_hi((unsigned)(m >> 32), __builtin_amdgcn_mbcnt_lo((unsigned)m, base))] = u[j];
                    base += (unsigned)__popcll(m);
                }
            }
        }
        asm volatile("s_waitcnt lgkmcnt(0)" ::: "memory");
        const unsigned uc = cbuf[lane];
#pragma unroll 1
        for (; bit >= 0; --bit) {
            const unsigned cand = thr | (1u << bit);
            const int cnt = hi_cnt + __popcll(__ballot(uc >= cand));
            if (cnt >= 256) { thr = cand; if (cnt == 256) { exact = true; break; } }
        }
    }
    if (thr == 0u) return false;
    int wlo = 0, whi = 0;
    if (exact) {
#pragma unroll
        for (int g = 0; g < 8; ++g) {
            if (8 * g < nj) {
#pragma unroll
                for (int j = 8 * g; j < 8 * g + 8; ++j) { const unsigned long long m = __ballot(u[j] >= thr); wlo = llvm_writelane_i32((int)(unsigned)m, j, wlo); whi = llvm_writelane_i32((int)(unsigned)(m >> 32), j, whi); }
            }
        }
    } else {
        int cgt = 0;
#pragma unroll
        for (int j = 0; j < 64; ++j) cgt += __popcll(__ballot(u[j] > thr));
        int need = 256 - cgt;
#pragma unroll
        for (int j = 0; j < 64; ++j) {
            const unsigned long long gtm = __ballot(u[j] > thr); unsigned long long eqm = __ballot(u[j] == thr);
            int pc = __popcll(eqm);
            while (pc > need) { eqm &= ~(1ull << (63 - __clzll((long long)eqm))); --pc; }
            need -= pc;
            const unsigned long long m = gtm | eqm;
            wlo = llvm_writelane_i32((int)(unsigned)m, j, wlo); whi = llvm_writelane_i32((int)(unsigned)(m >> 32), j, whi);
        }
    }
    mrow[lane] = ((unsigned long long)(unsigned)whi << 32) | (unsigned long long)(unsigned)wlo;
    return true;
}
namespace fa {
typedef short bf16x8 __attribute__((ext_vector_type(8)));
typedef short s16x4 __attribute__((ext_vector_type(4)));
typedef float f32x16 __attribute__((ext_vector_type(16)));
constexpr int SHM_K = 16384, SHM_V = 16384, SHM_KR = 8192;
constexpr int NVB = 3;
constexpr int L_V = 0, L_K = NVB * SHM_V, L_KR = L_K + 2 * SHM_K, L_WS = L_KR + 2 * SHM_KR, L_TAB = L_WS + 8 * 256, TAB_N = 4416, L_END = L_TAB + TAB_N * 4;
static_assert(L_END <= 131072, "attention LDS map");
#define FA_KSWZ(row, colB) ((row) * 256 + ((colB) ^ (((row) & 7) << 4)))
#define FA_KRSWZ(row, colB) ((row) * 128 + ((colB) ^ (((row) & 7) << 4)))
#define FA_SBAR() __builtin_amdgcn_sched_barrier(0)
__device__ __forceinline__ int v_st(int k, int c) { const int kk = (k & ~0xC) | ((k & 4) << 1) | ((k & 8) >> 1); return ((kk >> 3) * 4 + (c >> 5)) * 512 + ((kk & 7) * 32 + (c & 31)) * 2; }
__device__ __forceinline__ int v_rd_base(int lane) { return ((lane & 3) << 3) | (((lane >> 2) & 3) << 6) | (((lane >> 4) & 1) << 5) | (((lane >> 5) & 1) << 8); }
constexpr int v_rd_off(int d0, int ks, int half) { return d0 * 512 + ks * 4096 + half * 2048; }
__device__ __forceinline__ int crow(int r, int hi) { return (r & 3) + 8 * (r >> 2) + 4 * hi; }
__device__ __forceinline__ unsigned cvtpk(float lo, float hi) { unsigned r; asm("v_cvt_pk_bf16_f32 %0, %1, %2" : "=v"(r) : "v"(lo), "v"(hi)); return r; }

#define FA_KRD(dst, addr, off) asm volatile("ds_read_b128 %0, %1 offset:%2" : "=&v"(dst) : "v"(addr), "i"(off) : "memory")
#define FA_LWAIT(n) do { asm volatile("s_waitcnt lgkmcnt(" #n ")" ::: "memory"); FA_SBAR(); } while (0)
template <int D0, int ND>
__device__ __forceinline__ void qkt_main(f32x16& p0, f32x16& p1, const LAS char* Kt, int r32, int hi, const bf16x8* qr) {
    unsigned kb[4];
#pragma unroll
    for (int dd = 0; dd < 4; ++dd) kb[dd] = (unsigned)(size_t)Kt + FA_KSWZ(r32, (dd * 16 + hi * 8) * 2);
    bf16x8 a0[2], a1[2];
#define FA_QRD(i) do { constexpr int d0_ = D0 + (i); FA_KRD(a0[(i) & 1], kb[d0_ & 3], (d0_ >> 2) * 128); FA_KRD(a1[(i) & 1], kb[d0_ & 3], (d0_ >> 2) * 128 + 32 * 256); } while (0)
#define FA_QMM(i) do { p0 = __builtin_amdgcn_mfma_f32_32x32x16_bf16(a0[(i) & 1], qr[i], p0, 0, 0, 0); p1 = __builtin_amdgcn_mfma_f32_32x32x16_bf16(a1[(i) & 1], qr[i], p1, 0, 0, 0); FA_SBAR(); } while (0)
    FA_QRD(0); FA_QRD(1);
    FA_LWAIT(2); FA_QMM(0); FA_QRD(2);
    FA_LWAIT(2); FA_QMM(1); FA_QRD(3);
    if constexpr (ND == 4) { FA_LWAIT(2); FA_QMM(2); FA_LWAIT(0); FA_QMM(3); }
    else {
        FA_LWAIT(2); FA_QMM(2); FA_QRD(4);
        FA_LWAIT(2); FA_QMM(3); FA_QRD(5);
        FA_LWAIT(2); FA_QMM(4); FA_QRD(6);
        FA_LWAIT(2); FA_QMM(5); FA_QRD(7);
        FA_LWAIT(2); FA_QMM(6); FA_LWAIT(0); FA_QMM(7);
    }
#undef FA_QMM
#undef FA_QRD
}
__device__ __forceinline__ void qkt_rope(f32x16& p0, f32x16& p1, const LAS char* Kt, int r32, int hi, const bf16x8* qr) {
    unsigned kb[4];
#pragma unroll
    for (int i = 0; i < 4; ++i) kb[i] = (unsigned)(size_t)Kt + FA_KRSWZ(r32, (i * 16 + hi * 8) * 2);
    bf16x8 a0[2], a1[2];
#define FA_QRD(i) do { FA_KRD(a0[(i) & 1], kb[i], 0); FA_KRD(a1[(i) & 1], kb[i], 32 * 128); } while (0)
#define FA_QMM(i) do { p0 = __builtin_amdgcn_mfma_f32_32x32x16_bf16(a0[(i) & 1], qr[i], p0, 0, 0, 0); p1 = __builtin_amdgcn_mfma_f32_32x32x16_bf16(a1[(i) & 1], qr[i], p1, 0, 0, 0); FA_SBAR(); } while (0)
    FA_QRD(0); FA_QRD(1);
    FA_LWAIT(2); FA_QMM(0); FA_QRD(2);
    FA_LWAIT(2); FA_QMM(1); FA_QRD(3);
    FA_LWAIT(2); FA_QMM(2); FA_LWAIT(0); FA_QMM(3);
#undef FA_QMM
#undef FA_QRD
}
__device__ __forceinline__ void pv_tile(f32x16* o, int vb0  , bf16x8 pa0, bf16x8 pa1, bf16x8 pa2, bf16x8 pa3) {
#define FA_TRRD(dst, off) asm volatile("ds_read_b64_tr_b16 %0, %1 offset:%2" : "=&v"(dst) : "v"(vb0), "i"(off) : "memory")
#define FA_RD8(S, ks) do { constexpr int b_ = v_rd_off(0, ks, 0); \
        FA_TRRD(S##l0, b_); FA_TRRD(S##h0, b_ + 2048); FA_TRRD(S##l1, b_ + 512); FA_TRRD(S##h1, b_ + 512 + 2048); FA_TRRD(S##l2, b_ + 1024); FA_TRRD(S##h2, b_ + 1024 + 2048); FA_TRRD(S##l3, b_ + 1536); FA_TRRD(S##h3, b_ + 1536 + 2048); } while (0)
#define FA_MM4(S, pa) do { \
        o[0] = __builtin_amdgcn_mfma_f32_32x32x16_bf16(pa, (bf16x8){S##l0[0], S##l0[1], S##l0[2], S##l0[3], S##h0[0], S##h0[1], S##h0[2], S##h0[3]}, o[0], 0, 0, 0);   \
        o[1] = __builtin_amdgcn_mfma_f32_32x32x16_bf16(pa, (bf16x8){S##l1[0], S##l1[1], S##l1[2], S##l1[3], S##h1[0], S##h1[1], S##h1[2], S##h1[3]}, o[1], 0, 0, 0);   \
        o[2] = __builtin_amdgcn_mfma_f32_32x32x16_bf16(pa, (bf16x8){S##l2[0], S##l2[1], S##l2[2], S##l2[3], S##h2[0], S##h2[1], S##h2[2], S##h2[3]}, o[2], 0, 0, 0);   \
        o[3] = __builtin_amdgcn_mfma_f32_32x32x16_bf16(pa, (bf16x8){S##l3[0], S##l3[1], S##l3[2], S##l3[3], S##h3[0], S##h3[1], S##h3[2], S##h3[3]}, o[3], 0, 0, 0); } while (0)
#define FA_WAITL(n) do { asm volatile("s_waitcnt lgkmcnt(" #n ")" ::: "memory"); FA_SBAR(); } while (0)
    s16x4 Al0, Al1, Al2, Al3, Ah0, Ah1, Ah2, Ah3, Bl0, Bl1, Bl2, Bl3, Bh0, Bh1, Bh2, Bh3;
    FA_RD8(A, 0); FA_RD8(B, 1);
    FA_WAITL(8); FA_MM4(A, pa0); FA_SBAR();
    FA_RD8(A, 2);
    FA_WAITL(8); FA_MM4(B, pa1); FA_SBAR();
    FA_RD8(B, 3);
    FA_WAITL(8); FA_MM4(A, pa2); FA_SBAR();
    FA_WAITL(0); FA_MM4(B, pa3);
#undef FA_WAITL
#undef FA_MM4
#undef FA_RD8
#undef FA_TRRD
}
__device__ __forceinline__ bool softmax_tile(f32x16& p0, f32x16& p1, float& m_reg, float& l_reg, float& alpha, bf16x8& pa0, bf16x8& pa1, bf16x8& pa2, bf16x8& pa3, float coff = 0.f) {
    float mx[8];
#pragma unroll
    for (int r = 0; r < 8; ++r) mx[r] = fmaxf(fmaxf(fmaxf(p0[r], p0[r + 8]), p1[r]), p1[r + 8]);
    float pmax = fmaxf(fmaxf(fmaxf(fmaxf(fmaxf(mx[0], mx[1]), mx[2]), fmaxf(fmaxf(mx[3], mx[4]), mx[5])), mx[6]), mx[7]);
    { auto rr = __builtin_amdgcn_permlane32_swap(__float_as_uint(pmax), __float_as_uint(pmax), false, false);
      pmax = fmaxf(__uint_as_float(rr[0]), __uint_as_float(rr[1])) + coff; }
    float mn; bool moved = false;
    if (__builtin_expect(__all((pmax - m_reg) <= 11.5f), 1)) { mn = m_reg; alpha = 1.f; }
    else { mn = fmaxf(m_reg, pmax); alpha = __builtin_amdgcn_exp2f(m_reg - mn); m_reg = mn; moved = true; }
    const float msub = mn - coff;
#pragma unroll
    for (int r = 0; r < 16; ++r) p0[r] = __builtin_amdgcn_exp2f(p0[r] - msub);
#pragma unroll
    for (int r = 0; r < 16; ++r) p1[r] = __builtin_amdgcn_exp2f(p1[r] - msub);
    float sm[8];
#pragma unroll
    for (int r = 0; r < 8; ++r) sm[r] = (p0[r] + p0[r + 8]) + (p1[r] + p1[r + 8]);
    float ps = ((sm[0] + sm[1]) + (sm[2] + sm[3])) + ((sm[4] + sm[5]) + (sm[6] + sm[7]));
    { auto rr = __builtin_amdgcn_permlane32_swap(__float_as_uint(ps), __float_as_uint(ps), false, false);
      ps = __uint_as_float(rr[0]) + __uint_as_float(rr[1]); }
    l_reg = l_reg * alpha + ps;
#define FA_PK4(P, B_, OUT) do { unsigned a0 = cvtpk(P[B_+0], P[B_+1]), a1 = cvtpk(P[B_+2], P[B_+3]);                          \
        unsigned b0 = cvtpk(P[B_+4], P[B_+5]), b1 = cvtpk(P[B_+6], P[B_+7]);                                             \
        auto r0 = __builtin_amdgcn_permlane32_swap(a0, b0, false, false); auto r1 = __builtin_amdgcn_permlane32_swap(a1, b1, false, false); \
        u32x4 w = {r0[0], r1[0], r0[1], r1[1]}; OUT = *reinterpret_cast<bf16x8*>(&w); } while (0)
    FA_PK4(p0, 0, pa0); FA_PK4(p0, 8, pa1); FA_PK4(p1, 0, pa2); FA_PK4(p1, 8, pa3);
#undef FA_PK4
    return moved;
}

template <int MODE>
__device__ __forceinline__ void attn_unit(const Frame& F, int l, int lane_in, int wid, int b, int h, int qb, unsigned* qctr, volatile LAS unsigned* qslot, int rs = 1, int ro = 0, int gp = 0) {
    int lane = lane_in; asm volatile("" : "+v"(lane));
    constexpr int QB = (MODE == 3) ? 128 : 256;
    constexpr int NQ = (MODE == 0) ? 12 : (MODE == 3) ? 4 : 8;
    constexpr bool TABLE = MODE != 0, BITS = MODE == 2, ROPE = MODE == 0, WIN = (MODE == 1 || MODE == 4);
    constexpr float C2 = ((MODE == 0) ? 0.07216878364870323f : (MODE == 3) ? 0.125f : 0.08838834764831845f) * LOG2E;
    const int tid = wid * 64 + lane, r32 = lane & 31, hi = lane >> 5;
    WS_LOCAL
    const int rb = b * 4096, q0 = qb * QB;
    const int map = (MODE == 3) ? (wid >> 2) : 0;
    const int qlo = q0 + ((MODE == 3) ? (wid & 3) * 32 : wid * 32);
    LAS char* const lds = (LAS char*)F.lds;
    LAS char* const V_lds = lds + L_V; LAS char* const K_lds = lds + L_K; LAS char* const KR_lds = lds + L_KR;
    LAS float* const li_l = (LAS float*)(lds + L_WS) + wid * 64; LAS float* const al_l = li_l + 32;
    LAS float* const tab = (LAS float*)(lds + L_TAB);
    const bf16_t* Qp; const bf16_t* Kp; const bf16_t* Vp; const bf16_t* KRp = nullptr; int kpitch;
    if (MODE == 0) { Qp = WSP(bf16_t, WS_QA) + (size_t)(rb + qlo + r32) * 768 + h * 192 + hi * 8; Kp = WSP(bf16_t, WS_KVA) + (size_t)rb * 1024 + h * 256; Vp = Kp + 128; KRp = WSP(bf16_t, WS_KR) + (size_t)rb * 64; kpitch = 1024; }
    else { const bf16_t* base = WSP(bf16_t, WS_QKV) + (size_t)((MODE == 2 ? 1 : MODE == 3 ? 2 : 0) * 3) * M * 512;
        const int rs_ = WIN ? rs : 1, ro_ = WIN ? ro : 0;
        Qp = base + (size_t)(rb + rs_ * (qlo + r32) + ro_) * 512 + h * 128 + map * 64 + hi * 8; Kp = base + (size_t)M * 512 + (size_t)(rb + ro_) * 512 + h * 128; Vp = base + (size_t)2 * M * 512 + (size_t)(rb + ro_) * 512 + h * 128; kpitch = 512 * rs_; }
    bf16x8 qr[NQ];
#pragma unroll
    for (int i = 0; i < NQ; ++i) qr[i] = *(const bf16x8*)(Qp + i * 16);
    const int j_hi = (q0 + QB - 1) / 64 + 1;
    const int j_lo = WIN ? ((q0 > 128) ? ((q0 - 128) >> 6) : 0) : 0;
    const int NT = j_hi - j_lo;
    float tv[9];
    if (TABLE) {
        const float* Tg = WIN ? WSP(float, WS_TB) + (gp * 4 + h) * 192 : WSP(float, WS_TCD) + ((MODE == 3 ? 4 : 0) + h) * 4096;
#pragma unroll
        for (int q = 0; q < 9; ++q) { const int d = 4095 - (tid + q * NWAVES * 64); const bool ok = d >= 0 && (!WIN || d <= 128); const float v = Tg[ok ? d : 0]; tv[q] = ok ? v : -__builtin_inff(); }
    }
    const int sr = tid >> 4, sc = (tid & 15) * 8, vst0 = v_st(sr, sc), vst1 = v_st(32 + sr, sc), kws = FA_KSWZ(sr, sc * 2);
    const int krow = tid >> 3, kch = tid & 7, krws = FA_KRSWZ(krow, kch * 16);
    const int vb0 = (int)(unsigned)(size_t)V_lds + v_rd_base(lane);
    const unsigned long long* bmp = WSP(unsigned long long, WS_BM) + (size_t)(rb + qlo + r32) * 64;
    bf16x8 st_k0, st_k1, st_v0, st_v1, st_kr; unsigned long long bm_cur = 0ull, bm_nxt = 0ull;
#define FA_STAGE_LOAD(k0_) do { const bf16_t* kp_ = Kp + (size_t)((k0_) + sr) * kpitch + sc; const bf16_t* vp_ = Vp + (size_t)((k0_) + sr) * kpitch + sc; \
        st_k0 = *(const bf16x8*)kp_; st_k1 = *(const bf16x8*)(kp_ + (size_t)32 * kpitch); st_v0 = *(const bf16x8*)vp_; st_v1 = *(const bf16x8*)(vp_ + (size_t)32 * kpitch); \
        if (ROPE) st_kr = *(const bf16x8*)(KRp + (size_t)((k0_) + krow) * 64 + kch * 8); if (BITS) bm_nxt = bmp[(k0_) >> 6]; } while (0)
#define FA_STAGE_WRITE(kbf, vbf) do { *(LAS bf16x8*)(K_lds + (kbf) * SHM_K + kws) = st_k0; *(LAS bf16x8*)(K_lds + (kbf) * SHM_K + kws + 32 * 256) = st_k1; \
        *(LAS bf16x8*)(V_lds + (vbf) * SHM_V + vst0) = st_v0; *(LAS bf16x8*)(V_lds + (vbf) * SHM_V + vst1) = st_v1; if (ROPE) *(LAS bf16x8*)(KR_lds + (kbf) * SHM_KR + krws) = st_kr; } while (0)
    float m_reg = -1e30f, l_reg = 0.f; f32x16 o[4] = {};
    const bool grpB = wid >= 4;
    FA_STAGE_LOAD(j_lo * 64);
    {
#pragma unroll
        for (int i = 0; i < NQ; ++i) { u32x4 w = __builtin_bit_cast(u32x4, qr[i]);
            w.x = cvtpk(bf_lo(w.x) * C2, bf_hi(w.x) * C2); w.y = cvtpk(bf_lo(w.y) * C2, bf_hi(w.y) * C2); w.z = cvtpk(bf_lo(w.z) * C2, bf_hi(w.z) * C2); w.w = cvtpk(bf_lo(w.w) * C2, bf_hi(w.w) * C2);
            qr[i] = __builtin_bit_cast(bf16x8, w); }
    }
    if (TABLE) {
#pragma unroll
        for (int q = 0; q < 9; ++q) { const int i = tid + q * NWAVES * 64; if (i < TAB_N) tab[i] = tv[q]; }
    }
    asm volatile("s_waitcnt vmcnt(0)" ::: "memory"); FA_STAGE_WRITE(0, 0); bm_cur = bm_nxt;
    __syncthreads();
    float alpha = 1.f; bf16x8 pa0 = {}, pa1 = {}, pa2 = {}, pa3 = {};
    int vbc = 0, vbp = 2;
    bool act_prev = false;
#pragma unroll 1
    for (int t = 0; t < NT; ++t) {
        const int k0 = (j_lo + t) * 64; const bool more = t + 1 < NT; const int kb = t & 1; const int vbn = (vbc == NVB - 1) ? 0 : vbc + 1;
        if (more) FA_STAGE_LOAD(k0 + 64);
        if (grpB && act_prev) { pv_tile(o, vb0 + vbp * SHM_V, pa0, pa1, pa2, pa3); FA_SBAR(); }
        const bool act = (k0 <= qlo + 31) && (!WIN || k0 + 63 >= qlo - 128);
        if (act) {
        f32x16 p0 = {}, p1 = {};
        if (MODE == 3) { if (map == 0) qkt_main<0, 4>(p0, p1, K_lds + kb * SHM_K, r32, hi, qr); else qkt_main<4, 4>(p0, p1, K_lds + kb * SHM_K, r32, hi, qr); }
        else qkt_main<0, 8>(p0, p1, K_lds + kb * SHM_K, r32, hi, qr);
        if (ROPE) qkt_rope(p0, p1, KR_lds + kb * SHM_KR, r32, hi, qr + (ROPE ? 8 : 0));
        const int dq = qlo + r32 - k0 - 4 * hi;
        float coff = 0.f;
        if (TABLE) {
            if (!WIN && qlo - (k0 + 63) >= 1513) coff = tab[0];
            else { const LAS float* tp = tab + (4095 - dq);
#pragma unroll
                for (int r = 0; r < 16; ++r) { const int c = (r & 3) + 8 * (r >> 2); p0[r] += tp[c]; p1[r] += tp[c + 32]; } }
            if (BITS) { const unsigned wlo = (unsigned)bm_cur >> (4 * hi), whi = (unsigned)(bm_cur >> 32) >> (4 * hi);
#pragma unroll
                for (int r = 0; r < 16; ++r) { const int c = (r & 3) + 8 * (r >> 2);
                    const unsigned m0_ = (unsigned)__builtin_amdgcn_sbfe(wlo, c, 1), m1_ = (unsigned)__builtin_amdgcn_sbfe(whi, c, 1);
                    p0[r] = __uint_as_float((__float_as_uint(p0[r]) & m0_) | (0xFF800000u & ~m0_)); p1[r] = __uint_as_float((__float_as_uint(p1[r]) & m1_) | (0xFF800000u & ~m1_)); } }
        } else {
            if (k0 + 63 > qlo) {
#pragma unroll
                for (int r = 0; r < 16; ++r) { const int c = (r & 3) + 8 * (r >> 2);
                    if (dq - c < 0) p0[r] = -__builtin_inff(); if (dq - c - 32 < 0) p1[r] = -__builtin_inff(); } }
        }
        const bool moved = softmax_tile(p0, p1, m_reg, l_reg, alpha, pa0, pa1, pa2, pa3, coff);
        if (moved) { if (hi == 0) al_l[r32] = alpha; asm volatile("s_waitcnt lgkmcnt(0)" ::: "memory");
#pragma unroll
            for (int r = 0; r < 16; ++r) { const float a_ = al_l[crow(r, hi)];
#pragma unroll
                for (int d_ = 0; d_ < 4; ++d_) o[d_][r] *= a_; } }
        FA_SBAR();
        if (!grpB) { pv_tile(o, vb0 + vbc * SHM_V, pa0, pa1, pa2, pa3); FA_SBAR(); }
        }
        act_prev = act;
        if (more) { asm volatile("s_waitcnt vmcnt(0)" ::: "memory"); FA_STAGE_WRITE(kb ^ 1, vbn); bm_cur = bm_nxt; }
        __syncthreads();
        vbp = vbc; vbc = vbn;
    }
    if (grpB && act_prev) pv_tile(o, vb0 + vbp * SHM_V, pa0, pa1, pa2, pa3);
    __syncthreads();
#undef FA_STAGE_LOAD
#undef FA_STAGE_WRITE
    unsigned q_next = 0u; if (tid == 0) q_next = atomicAdd(qctr, 1u);
    u32x4 gv[8]; u32x4 p1v[8], p2v[8]; float e1 = 0.f, e2 = 0.f;
    if (MODE != 4 && (MODE != 3 || map == 0)) {
        const bf16_t* const Mr = WSP(bf16_t, WS_MIXED) + (size_t)(rb + qlo) * 2048 + (MODE == 1 ? 512 : MODE * 512) + h * 128;
#pragma unroll
        for (int i = 0; i < 8; ++i) { const int c = lane + 64 * i, row = c >> 4, col8 = (c & 15) * 8; gv[i] = *(const u32x4*)(Mr + (size_t)row * 2048 + col8); }
        if (MODE == 1) {
            const bf16_t* const P1 = WSP(bf16_t, WS_PB) + (size_t)(rb + qlo) * 512 + h * 128; const bf16_t* const P2 = P1 + (size_t)M * 512;
#pragma unroll
            for (int i = 0; i < 8; ++i) { const int c = lane + 64 * i, row = c >> 4, col8 = (c & 15) * 8; p1v[i] = *(const u32x4*)(P1 + (size_t)row * 512 + col8); p2v[i] = *(const u32x4*)(P2 + (size_t)row * 512 + col8); }
            const size_t rowg = (size_t)(rb + qlo + r32);
            e1 = WSP(float, WS_LSE)[rowg * 4 + h]; e2 = WSP(float, WS_LSE)[((size_t)M + rowg) * 4 + h];
        }
    }
    if (hi == 0) li_l[r32] = l_reg; asm volatile("s_waitcnt lgkmcnt(0)" ::: "memory");
    float rli[16];
#pragma unroll
    for (int r = 0; r < 16; ++r) rli[r] = __builtin_amdgcn_rcpf(li_l[crow(r, hi)]);
#pragma unroll
    for (int d0 = 0; d0 < 4; ++d0)
#pragma unroll
        for (int r = 0; r < 16; ++r) o[d0][r] *= rli[r];
    if (MODE == 3) {
        LAS float* xb = (LAS float*)lds + (size_t)(wid & 3) * 4096 + lane;
        if (map == 1) {
#pragma unroll
            for (int d0 = 0; d0 < 4; ++d0)
#pragma unroll
                for (int r = 0; r < 16; ++r) xb[(d0 * 16 + r) * 64] = o[d0][r];
        }
        __syncthreads();
        if (map == 0) {
            const float lam = WSP(float, WS_CONST)[l];
            const float li = (l == 0) ? 0.2f : 0.35550906759096926f;
#pragma unroll
            for (int d0 = 0; d0 < 4; ++d0)
#pragma unroll
                for (int r = 0; r < 16; ++r) o[d0][r] -= lam * xb[(d0 * 16 + r) * 64];
            const float* gs = FIN(15) + l * 128;
            float g4[4];
#pragma unroll
            for (int d0 = 0; d0 < 4; ++d0) g4[d0] = gs[d0 * 32 + r32] * (1.0f - li);
#pragma unroll
            for (int r = 0; r < 16; ++r) {
                float ss = (o[0][r] * o[0][r] + o[1][r] * o[1][r]) + (o[2][r] * o[2][r] + o[3][r] * o[3][r]);
                DPP_ADD(ss, 0xB1); DPP_ADD(ss, 0x4E); DPP_ADD(ss, 0x141); DPP_ADD(ss, 0x140);
                { auto rr_ = __builtin_amdgcn_permlane16_swap(__float_as_uint(ss), __float_as_uint(ss), false, false); ss = __uint_as_float(rr_[0]) + __uint_as_float(rr_[1]); }
                const float rs = __builtin_amdgcn_rsqf(ss * (1.0f / 128.0f) + 1e-6f);
#pragma unroll
                for (int d0 = 0; d0 < 4; ++d0) o[d0][r] *= rs * g4[d0];
            }
        }
    }
    if (MODE != 3 || map == 0) {
        LAS char* const stg = lds + ((MODE == 3) ? 65536 + wid * 8192 : wid * 8192);
#pragma unroll
        for (int r = 0; r < 16; ++r) { const int orow = crow(r, hi);
#pragma unroll
            for (int d0 = 0; d0 < 4; ++d0) { const float v = o[d0][r];
                const float vn = __builtin_bit_cast(float, __builtin_amdgcn_update_dpp(0, __builtin_bit_cast(int, v), 0xB1, 0xF, 0xF, true));
                if ((r32 & 1) == 0) *(LAS unsigned*)(stg + (orow * 128 + d0 * 32 + r32) * 2) = cvtpk(v, vn); } }
        if (MODE == 4) {
            asm volatile("s_waitcnt lgkmcnt(0)" ::: "memory");
            bf16_t* const Pw = WSP(bf16_t, WS_PB) + (size_t)(gp - 1) * M * 512 + h * 128;
#pragma unroll
            for (int i = 0; i < 8; ++i) { const int c = lane + 64 * i, row = c >> 4, col8 = (c & 15) * 8;
                *(u32x4*)(Pw + (size_t)(rb + rs * (qlo + row) + ro) * 512 + col8) = *(const LAS u32x4*)(stg + row * 256 + col8 * 2); }
            if (hi == 0) WSP(float, WS_LSE)[((size_t)(gp - 1) * M + (rb + rs * (qlo + r32) + ro)) * 4 + h] = m_reg + __builtin_amdgcn_logf(l_reg);
        } else if (MODE == 1) {
            LAS float* const wts = (LAS float*)(lds + 65536 + wid * 512);
            if (hi == 0) {
                const float e0 = m_reg + __builtin_amdgcn_logf(l_reg);
                const float mx = fmaxf(fmaxf(e0, e1), e2);
                const float w0 = __builtin_amdgcn_exp2f(e0 - mx), w1 = __builtin_amdgcn_exp2f(e1 - mx), w2 = __builtin_amdgcn_exp2f(e2 - mx);
                const float inv = __builtin_amdgcn_rcpf(w0 + w1 + w2);
                *(LAS f32x4*)(wts + r32 * 4) = (f32x4){w0 * inv, w1 * inv, w2 * inv, 0.f};
            }
            asm volatile("s_waitcnt lgkmcnt(0)" ::: "memory");
            bf16_t* const Mw = WSP(bf16_t, WS_MIXED) + (size_t)(rb + qlo) * 2048 + 512 + h * 128;
            u32x4 ov[8];
#pragma unroll
            for (int i = 0; i < 8; ++i) { const int c = lane + 64 * i, row = c >> 4, col8 = (c & 15) * 8; ov[i] = *(const LAS u32x4*)(stg + row * 256 + col8 * 2); }
#pragma unroll
            for (int i = 0; i < 8; ++i) { const int c = lane + 64 * i, row = c >> 4, col8 = (c & 15) * 8;
                const f32x4 w = *(const LAS f32x4*)(wts + row * 4);
#define FA_MIX(O, A, B, G, sel) ((w[0] * sel(O) + w[1] * sel(A) + w[2] * sel(B)) * sel(G))
                u32x4 q;
                q.x = cvtpk(FA_MIX(ov[i].x, p1v[i].x, p2v[i].x, gv[i].x, bf_lo), FA_MIX(ov[i].x, p1v[i].x, p2v[i].x, gv[i].x, bf_hi));
                q.y = cvtpk(FA_MIX(ov[i].y, p1v[i].y, p2v[i].y, gv[i].y, bf_lo), FA_MIX(ov[i].y, p1v[i].y, p2v[i].y, gv[i].y, bf_hi));
                q.z = cvtpk(FA_MIX(ov[i].z, p1v[i].z, p2v[i].z, gv[i].z, bf_lo), FA_MIX(ov[i].z, p1v[i].z, p2v[i].z, gv[i].z, bf_hi));
                q.w = cvtpk(FA_MIX(ov[i].w, p1v[i].w, p2v[i].w, gv[i].w, bf_lo), FA_MIX(ov[i].w, p1v[i].w, p2v[i].w, gv[i].w, bf_hi));
#undef FA_MIX
                *(u32x4*)(Mw + (size_t)row * 2048 + col8) = q; }
        } else {
        asm volatile("s_waitcnt lgkmcnt(0)" ::: "memory");
        bf16_t* const Mw = WSP(bf16_t, WS_MIXED) + (size_t)(rb + qlo) * 2048 + MODE * 512 + h * 128;
        u32x4 ov[8];
#pragma unroll
        for (int i = 0; i < 8; ++i) { const int c = lane + 64 * i, row = c >> 4, col8 = (c & 15) * 8; ov[i] = *(const LAS u32x4*)(stg + row * 256 + col8 * 2); }
#pragma unroll
        for (int i = 0; i < 8; ++i) { const int c = lane + 64 * i, row = c >> 4, col8 = (c & 15) * 8;
            u32x4 w;
            w.x = cvtpk(bf_lo(ov[i].x) * bf_lo(gv[i].x), bf_hi(ov[i].x) * bf_hi(gv[i].x)); w.y = cvtpk(bf_lo(ov[i].y) * bf_lo(gv[i].y), bf_hi(ov[i].y) * bf_hi(gv[i].y));
            w.z = cvtpk(bf_lo(ov[i].z) * bf_lo(gv[i].z), bf_hi(ov[i].z) * bf_hi(gv[i].z)); w.w = cvtpk(bf_lo(ov[i].w) * bf_lo(gv[i].w), bf_hi(ov[i].w) * bf_hi(gv[i].w));
            *(u32x4*)(Mw + (size_t)row * 2048 + col8) = w; }
        }
    }
    if (tid == 0) *qslot = q_next;
    __syncthreads();
}
#undef FA_KSWZ
#undef FA_KRSWZ
#undef FA_SBAR
}

__device__ __forceinline__ int queue_next(unsigned* ctr, volatile LAS unsigned* slot, int tid) {
    if (tid == 0) *slot = atomicAdd(ctr, 1u);
    __syncthreads();
    const int v = (int)*slot;
    __syncthreads();
    return v;
}
__device__ __forceinline__ void p_attn_group1(const Frame& F, int l) {
    PHASE_LOCALS
    unsigned* ctr = (unsigned*)(ws_l + WS_CTL + 16384 + (l * 4 + 3) * 256);
    volatile LAS unsigned* slot = (volatile LAS unsigned*)(F.lds + MISC_OFF) + 16;
    int it = queue_next(ctr, slot, tid);
    while (it < 1024) {
        const int bh = it & 15;
        if (it < 512) fa::attn_unit<3>(F, l, lane, wave, bh >> 2, bh & 3, 31 - (it >> 4), ctr, slot);
        else { const int j = it - 512; const bool p4 = j < 256;
            fa::attn_unit<4>(F, l, lane, wave, bh >> 2, bh & 3, p4 ? 3 - (j >> 6) : 0, ctr, slot, p4 ? 4 : 16, p4 ? (j >> 4) & 3 : (j - 256) >> 4, p4 ? 1 : 2); }
        it = (int)*slot;
    }
    __syncthreads();
}
__device__ __forceinline__ void p_attn_group2(const Frame& F, int l) {
    PHASE_LOCALS
    unsigned* ctr = (unsigned*)(ws_l + WS_CTL + 16384 + (l * 4 + 0) * 256);
    volatile LAS unsigned* slot = (volatile LAS unsigned*)(F.lds + MISC_OFF) + 16;
    int it = queue_next(ctr, slot, tid);
    while (it < 768) {
        const int bh = it & 15, qb = 15 - ((it >> 4) & 15);
        if (it < 256) fa::attn_unit<0>(F, l, lane, wave, bh >> 2, bh & 3, qb, ctr, slot);
        else if (it < 512) fa::attn_unit<2>(F, l, lane, wave, bh >> 2, bh & 3, qb, ctr, slot);
        else fa::attn_unit<1>(F, l, lane, wave, bh >> 2, bh & 3, qb, ctr, slot);
        it = (int)*slot;
    }
    __syncthreads();
}

namespace ix {
using fa::bf16x8; using fa::f32x16;
constexpr int KB = 3;
constexpr int L_Q = 0, L_W = 65536;
__device__ __forceinline__ void index_item(const Frame& F, int lane_in, int wid, int b, int qi, float* scr, int pitch  ) {
    int lane = lane_in; asm volatile("" : "+v"(lane));
    WS_LOCAL
    const int tid = wid * 64 + lane, r32 = lane & 31, hi = lane >> 5;
    const int rb = b * 4096, q0 = qi * 32;
    LAS char* const lds = (LAS char*)F.lds;
    {
        const int r = tid >> 4;
        const bf16_t* src = WSP(bf16_t, WS_IDXQ) + (size_t)(rb + q0 + r) * 1024;
#pragma unroll
        for (int i = 0; i < 8; ++i) { const int c = (tid & 15) + 16 * i; const bf16x8 v = *(const bf16x8*)(src + c * 8); *(LAS bf16x8*)(lds + L_Q + r * 2048 + ((c ^ (r & 15)) << 4)) = v; }
        ((LAS float*)(lds + L_W))[(tid & 15) * 32 + r] = WSP(float, WS_IDXW)[(size_t)(rb + q0 + r) * 16 + (tid & 15)];
    }
    __syncthreads();
    const int nkb = qi + 1;
    unsigned abase[4];
#pragma unroll
    for (int s = 0; s < 4; ++s) abase[s] = (unsigned)(size_t)(lds + L_Q) + r32 * 2048 + (((2 * s + hi) ^ (r32 & 15)) << 4);
    const bf16_t* kbase = WSP(bf16_t, WS_IDXK) + (size_t)(rb + r32) * 64 + 8 * hi;
    const LAS float* wrow = (const LAS float*)(lds + L_W) + r32;
#define IX_LDA(dst, hh) do { _Pragma("unroll") for (int s = 0; s < 4; ++s) dst[s] = *(const LAS bf16x8*)(size_t)((abase[s] ^ ((unsigned)((hh) & 1) << 7)) + (unsigned)((hh) >> 1) * 256u); } while (0)
#define IX_RELU(x) __int_as_float(max(__float_as_int(x), 0))
#define IX_BLKA(MMA, ACC, AH, WV) do { _Pragma("unroll") for (int s = 0; s < 4; ++s) { \
        if (MMA) { dA0 = __builtin_amdgcn_mfma_f32_32x32x16_bf16(kf[0][s], AH[s], s == 0 ? f32x16{} : dA0, 0, 0, 0); dA1 = __builtin_amdgcn_mfma_f32_32x32x16_bf16(kf[1][s], AH[s], s == 0 ? f32x16{} : dA1, 0, 0, 0); } \
        if (ACC) { _Pragma("unroll") for (int i = 4 * s; i < 4 * s + 4; ++i) score[2][i] = fmaf(IX_RELU(dB[i]), WV, score[2][i]); } } } while (0)
#define IX_BLKB(AH, WV) do { _Pragma("unroll") for (int s = 0; s < 4; ++s) { \
        dB = __builtin_amdgcn_mfma_f32_32x32x16_bf16(kf[2][s], AH[s], s == 0 ? f32x16{} : dB, 0, 0, 0); \
        _Pragma("unroll") for (int i = 4 * s; i < 4 * s + 4; ++i) { score[0][i] = fmaf(IX_RELU(dA0[i]), WV, score[0][i]); score[1][i] = fmaf(IX_RELU(dA1[i]), WV, score[1][i]); } } } while (0)
    for (int kb0 = wid * KB; kb0 < nkb; kb0 += NWAVES * KB) {
        bf16x8 kf[KB][4];
#pragma unroll
        for (int kbi = 0; kbi < KB; ++kbi)
#pragma unroll
            for (int s = 0; s < 4; ++s) { kf[kbi][s] = (bf16x8){0, 0, 0, 0, 0, 0, 0, 0}; if (kb0 + kbi < nkb) kf[kbi][s] = *(const bf16x8*)(kbase + (size_t)(kb0 + kbi) * 32 * 64 + 16 * s); }
        f32x16 score[KB];
#pragma unroll
        for (int kbi = 0; kbi < KB; ++kbi) score[kbi] = f32x16{};
        bf16x8 a0[4], a1[4]; f32x16 dA0, dA1, dB; float w0, w1;
        IX_LDA(a0, 0); w0 = wrow[0]; IX_LDA(a1, 1); w1 = wrow[32];
        IX_BLKA(true, false, a0, w0);
#pragma unroll 1
        for (int h = 0; h < 14; h += 2) {
            IX_BLKB(a0, w0);
            IX_LDA(a0, h + 2);
            IX_BLKA(true, true, a1, w0);
            w0 = wrow[(h + 2) * 32];
            IX_BLKB(a1, w1);
            IX_LDA(a1, h + 3);
            IX_BLKA(true, true, a0, w1);
            w1 = wrow[(h + 3) * 32];
        }
        IX_BLKB(a0, w0);
        IX_BLKA(true, true, a1, w0);
        IX_BLKB(a1, w1);
        IX_BLKA(false, true, a0, w1);
        int kbs = kb0, pit = pitch; asm volatile("" : "+s"(kbs), "+s"(pit));
#pragma unroll
        for (int kbi = 0; kbi < KB; ++kbi) {
            if (kbs + kbi < nkb) {
                float* dst = scr + (size_t)r32 * pit + (size_t)(kbs + kbi) * 32 + 4 * hi;
#pragma unroll
                for (int g = 0; g < 4; ++g) *(f32x4*)(dst + 8 * g) = (f32x4){score[kbi][4 * g], score[kbi][4 * g + 1], score[kbi][4 * g + 2], score[kbi][4 * g + 3]};
            }
        }
    }
#undef IX_LDA
#undef IX_RELU
#undef IX_BLKA
#undef IX_BLKB
    asm volatile("s_waitcnt vmcnt(0)" ::: "memory");
    __syncthreads();
    __builtin_amdgcn_fence(__ATOMIC_ACQUIRE, "agent");
    asm volatile("s_waitcnt vmcnt(0)" ::: "memory");
#pragma unroll 1
    for (int rr = 0; rr < 4; ++rr) {
        const int row = wid * 4 + rr, pos = q0 + row;
        const float* srow = scr + (size_t)(row * pitch) + lane;
        const int js = pos >> 6;
        float sv[64];
#pragma unroll
        for (int g = 0; g < 8; ++g) {
            if (64 * 8 * g <= pos) {
#pragma unroll
                for (int q = 0; q < 8; ++q) sv[8 * g + q] = srow[64 * (8 * g + q)];
            } else {
#pragma unroll
                for (int q = 0; q < 8; ++q) sv[8 * g + q] = 0.f;
            }
        }
        unsigned uk[64];
#pragma unroll
        for (int g = 0; g < 8; ++g) {
            if (8 * g + 7 < js) {
#pragma unroll
                for (int j = 8 * g; j < 8 * g + 8; ++j) uk[j] = score_key(sv[j]);
            } else if (8 * g <= js) {
#pragma unroll
                for (int j = 8 * g; j < 8 * g + 8; ++j) uk[j] = (64 * j + lane <= pos) ? score_key(sv[j]) : 0u;
            } else {
#pragma unroll
                for (int j = 8 * g; j < 8 * g + 8; ++j) uk[j] = 0u;
            }
        }
        select_row(uk, pos, WSP(unsigned long long, WS_BM) + (size_t)(rb + pos) * 64, lane, (LAS unsigned*)(lds + L_W + 4096) + wid * 64);
    }
    __syncthreads();
}
}
__device__ __forceinline__ void p_index_fast(const Frame& F) {
    PHASE_LOCALS
    for (int w = bid; w < 256; w += G_l) {
    const int a = (w >> 2) & 63, b = w & 3, nkbig = 128 - a;
    float* scr = (float*)(ws_l + WS_SCR + (size_t)16384 * (128 * a - (a * (a - 1)) / 2) + (size_t)b * nkbig * 4096);
    ix::index_item(F, lane, wave, b, 127 - a, scr, 32 * nkbig);
    ix::index_item(F, lane, wave, b, a, scr, 32 * nkbig);
    }
}
template <int PH_LO, int PH_HI>
__global__ void __launch_bounds__(NWAVES * 64, 2) fwd_kernel(Args args) {
    extern __shared__ __attribute__((aligned(16))) unsigned char lds_raw[];
    Frame F;
    F.lds = (LAS unsigned char*)lds_raw;
    F.wave = __builtin_amdgcn_readfirstlane((int)threadIdx.x >> 6);
    F.G = gridDim.x; { const int bx = blockIdx.x; F.vcu = (F.G % 8 == 0) ? (bx % 8) * (F.G / 8) + bx / 8 : bx; }
    F.a = &args; F.out = args.out; F.ws = args.ws;
    volatile LAS unsigned* MISC = (volatile LAS unsigned*)(F.lds + MISC_OFF);
    if (threadIdx.x < 64) MISC[threadIdx.x] = 0u;
    __syncthreads();
    constexpr int lo = PH_LO, hi = PH_HI;
    constexpr bool use_bar = (hi - lo) > 1;
    XcdBarrier bar; bar.bar = (unsigned*)(F.ws + WS_CTL); bar.x = 0; bar.st = MISC + 8;
    if (use_bar) bar = xcd_barrier_post((unsigned*)(F.ws + WS_CTL), MISC + 8);
    bar.wave0 = F.wave;
#define IN(k) (lo <= (k) && (k) < hi)
#define SEAM(k) do { if constexpr (IN(k) && IN((k) + 1)) { XcdBarrier b2_ = bar; asm volatile("" : "+s"(b2_.bar), "+s"(b2_.x)); xcd_barrier(b2_); } } while (0)
    if constexpr (IN(0)) { p0_prologue(F); } SEAM(0);
    if constexpr (IN(1)) { p_pre0(F); } SEAM(1);
#define LAYER_PHASES(l_)                                                                                                                                      \
    { constexpr int l = (l_); constexpr int pb = 2 + 5 * l;                                                                                                    \
        if constexpr (IN(pb))     { p_gemm1(F, l); } SEAM(pb);                                                                           \
        if constexpr (IN(pb + 1)) { p_upq(F, l); __syncthreads(); p_upkv(F, l); __syncthreads(); p_index_fast(F); __syncthreads();                             \
                                    p_attn_group1(F, l); } SEAM(pb + 1);                        \
        if constexpr (IN(pb + 2)) { p_attn_group2(F, l); } SEAM(pb + 2);                                          \
        if constexpr (IN(pb + 3)) { p_gemm2(F, l); } SEAM(pb + 3);                                                                      \
        if constexpr (IN(pb + 4)) { p_post(F, l); } SEAM(pb + 4);                                                        \
    }
    LAYER_PHASES(0)
    LAYER_PHASES(1)
}

extern "C" void kernel_launch(void* const* d_in, const int* in_sizes, int n_in, void* d_out, int out_size, void* d_ws, size_t ws_size, hipStream_t stream) {
    static int grid = 0;
    if (grid == 0) {
        if (n_in != 18 || out_size != M * DM || ws_size < WS_END) { fprintf(stderr, "kernel_launch: unexpected problem (n_in %d, out %d, ws %zu < %zu)\n", n_in, out_size, ws_size, (size_t)WS_END); grid = -1; return; }
        int dev = 0, cus = 0, per_cu = 0;
        if (hipGetDevice(&dev) != hipSuccess || hipDeviceGetAttribute(&cus, hipDeviceAttributeMultiprocessorCount, dev) != hipSuccess) { grid = -1; return; }
        if (hipFuncSetAttribute((const void*)fwd_kernel<0, N_PHASES>, hipFuncAttributeMaxDynamicSharedMemorySize, LDS_BYTES) != hipSuccess) { fprintf(stderr, "kernel_launch: hipFuncSetAttribute failed\n"); grid = -1; return; }
        if (hipOccupancyMaxActiveBlocksPerMultiprocessor(&per_cu, (const void*)fwd_kernel<0, N_PHASES>, NWAVES * 64, LDS_BYTES) != hipSuccess || per_cu < 1) { fprintf(stderr, "kernel_launch: occupancy query reports %d\n", per_cu); }
        (void)hipGetLastError();
        grid = cus;
    }
    if (grid < 0) return;
    if (hipMemsetAsync((char*)d_ws, 0, ZERO_BYTES, stream) != hipSuccess) { fprintf(stderr, "kernel_launch: memset failed\n"); return; }
    Args a{};
    for (int i = 0; i < 18; ++i) a.in[i] = (const float*)d_in[i];
    a.out = (float*)d_out; a.ws = (unsigned char*)d_ws;
    a.ph_lo = 0; a.ph_hi = N_PHASES;
    hipLaunchKernelGGL((fwd_kernel<0, N_PHASES>), dim3(grid), dim3(NWAVES * 64), LDS_BYTES, stream, a);
    const hipError_t le = hipPeekAtLastError();
    if (le != hipSuccess) fprintf(stderr, "kernel_launch: launch failed: %s\n", hipGetErrorName(le));
}
```

```cpp
#include <hip/hip_runtime.h>
#include <cstdio>
#include <cstdint>
constexpr int M = 16384, NW1 = 8704;
constexpr size_t al256(size_t x) { return (x + 255) & ~(size_t)255; }
constexpr size_t WS_CTL = 0;
constexpr size_t CTL_BYTES = 65536;
constexpr size_t WS_MOD = WS_CTL + CTL_BYTES;
constexpr size_t WS_SSQ = WS_MOD + al256(2 * 4 * 6144 * 4);
constexpr size_t WS_SSKV = WS_SSQ + (size_t)M * 8 * 4;
constexpr size_t WS_SSEND = WS_SSKV + (size_t)M * 4 * 4;
constexpr size_t ZERO_BYTES = CTL_BYTES;
constexpr size_t WS_CONST = WS_SSEND;
constexpr size_t WS_ROPE = WS_CONST + 256;
constexpr size_t WS_TCD = WS_ROPE + (size_t)4096 * 32 * 8;
constexpr size_t WS_TB = WS_TCD + (size_t)8 * 4096 * 4;
constexpr size_t WS_WTOUT = WS_TB + (size_t)4 * 2560 * 4;
constexpr size_t WS_WTUQ = WS_WTOUT + (size_t)2 * 2048 * 2048 * 2;
constexpr size_t WS_WTUKV = WS_WTUQ + (size_t)2 * 768 * 384 * 2;
constexpr size_t WTIN_BYTES = (size_t)NW1 * 2048 * 2;
constexpr size_t WS_WTIN1 = WS_WTUKV + (size_t)2 * 1024 * 256 * 2;
constexpr size_t WS_WTIN0 = WS_WTIN1 + WTIN_BYTES;
constexpr size_t WS_H = WS_WTIN0 + WTIN_BYTES;
constexpr size_t WS_SCR = WS_WTIN0;
constexpr size_t SCR_BYTES = WTIN_BYTES + (size_t)M * 2048 * 2;
static_assert((size_t)16384 * 6176 <= SCR_BYTES, "indexer scratch: 256 compact slots");
constexpr size_t WS_MIXED = WS_H + (size_t)M * 2048 * 2;
constexpr size_t WS_CKV = WS_MIXED + (size_t)M * 2048 * 2;
constexpr size_t WS_CQ = WS_CKV + (size_t)M * 256 * 2;
constexpr size_t WS_KR = WS_CQ + (size_t)M * 384 * 2;
constexpr size_t WS_IDXK = WS_KR + (size_t)M * 64 * 2;
constexpr size_t WS_IDXW = WS_IDXK + (size_t)M * 64 * 2;
constexpr size_t WS_IDXQ = WS_IDXW + (size_t)M * 16 * 4;
constexpr size_t WS_QKV = WS_IDXQ + (size_t)M * 1024 * 2;
constexpr size_t WS_QA = WS_QKV + (size_t)9 * M * 512 * 2;
constexpr size_t WS_KVA = WS_QA + (size_t)M * 768 * 2;
constexpr size_t WS_BM = WS_KVA + (size_t)M * 1024 * 2;
constexpr size_t WS_PB = WS_BM + (size_t)M * 64 * 8;
constexpr size_t WS_LSE = WS_PB + (size_t)2 * M * 512 * 2;
constexpr size_t WS_END = WS_LSE + (size_t)2 * M * 4 * 4;
constexpr size_t WS_Y = WS_QKV;
static_assert((size_t)M * 2048 * 4 <= (size_t)9 * M * 512 * 2, "Y overlay");

namespace pg8 { constexpr size_t OFF_CKV = WS_CKV, OFF_CQ = WS_CQ, OFF_KR = WS_KR, OFF_IDXK = WS_IDXK, OFF_IDXQ = WS_IDXQ, OFF_QKV = WS_QKV, OFF_MIXED = WS_MIXED, OFF_IDXW = WS_IDXW,
    OFF_SSQ = WS_SSQ, OFF_SSKV = WS_SSKV, OFF_ROPE = WS_ROPE, OFF_QA = WS_QA, OFF_KVA = WS_KVA, OFF_Y = WS_Y; }
__device__ __forceinline__ int fresh_lane() { unsigned ones = ~0u; asm volatile("" : "+s"(ones)); return (int)__builtin_amdgcn_mbcnt_hi(ones, __builtin_amdgcn_mbcnt_lo(ones, 0u)); }
namespace pg8 {
#define PG8_LAS __attribute__((address_space(3)))
typedef unsigned short bf16_t;
typedef short bf16x8 __attribute__((ext_vector_type(8)));
typedef float f32x4 __attribute__((ext_vector_type(4)));
typedef unsigned u32x4 __attribute__((ext_vector_type(4)));
constexpr int BM = 256, BK = 64, HALF = 128, HTB = HALF * BK * 2  , STAGE_BYTES = 8 * HTB, NXCD = 8, WGM = 8;

__host__ __device__ __forceinline__ int lds_byte(int r, int c) { const int st = (r >> 4) * 2 + (c >> 5), rr = r & 15, cc = c & 31, ob = rr * 64 + cc * 2; return st * 1024 + (ob ^ (((ob >> 9) & 1) << 5)); }
__host__ __device__ __forceinline__ void stage_rc(int b, int& R, int& C) { const int st = b / 1024, sb = b % 1024, swz = sb ^ (((sb >> 9) & 1) << 5); R = (st >> 1) * 16 + swz / 64; C = (st & 1) * 32 + (swz % 64) / 2; }
__host__ __device__ __forceinline__ int perm32(int rho) { const int n = rho >> 4, i = rho & 15; return 8 * (i >> 2) + 4 * n + (i & 3); }

struct Unit { int pm, pn, hs; };
struct Gemm { const bf16_t* A; const bf16_t* Bt; int M, N, K; };

struct StaticOrder {
    int nM, nN, nwg, G, c;
    __host__ __device__ void init(int M, int N, int G_, int c_) { nM = M / BM; nN = N / BM; nwg = nM * nN; G = G_; c = c_; }
    __host__ __device__ bool next(int i, Unit& u) const {
        const long L = (long)i * G + c; if (L >= nwg) return false;
        int wgid = (int)L; { const int q = nwg / NXCD, r = nwg % NXCD, xcd = wgid % NXCD, off = wgid / NXCD; wgid = (xcd < r ? xcd * (q + 1) : r * (q + 1) + (xcd - r) * q) + off; }
        const int nig = WGM * nN, gid = wgid / nig, fm = gid * WGM, gsz = (nM - fm) < WGM ? (nM - fm) : WGM;
        u.pm = fm + ((wgid % nig) % gsz); u.pn = ((wgid % nig) / gsz + 4 * gid) % nN; u.hs = 0; return true;
    }
    __device__ __forceinline__ void a_ready(const Unit&) const {}
    __device__ __forceinline__ void done(const Unit&) const {}
};
struct TailOrder {
    int c;
    __device__ __forceinline__ bool next(int i, Unit& u) const { if (i > 0) return false; const int g = c & 7, w = c >> 3; u.pm = 8 * g + ((w >> 1) & 7); u.pn = 32 + (w >> 4); u.hs = w & 1; return true; }
    __device__ __forceinline__ void a_ready(const Unit&) const {}
    __device__ __forceinline__ void done(const Unit&) const {}
};

__device__ __forceinline__ unsigned cvt_pk_bf16(float lo, float hi) { unsigned r; asm volatile("v_cvt_pk_bf16_f32 %0, %1, %2" : "=v"(r) : "v"(lo), "v"(hi)); return r; }
typedef float f32x2 __attribute__((ext_vector_type(2)));
__device__ __forceinline__ float silu_f(float v) { return v * __builtin_amdgcn_rcpf(1.0f + __builtin_amdgcn_exp2f(-1.4426950408889634f * v)); }
__device__ __forceinline__ u32x4 pack8bf(const f32x4& a, const f32x4& b) { u32x4 w; w.x = cvt_pk_bf16(a[0], a[1]); w.y = cvt_pk_bf16(a[2], a[3]); w.z = cvt_pk_bf16(b[0], b[1]); w.w = cvt_pk_bf16(b[2], b[3]); return w; }

enum { EM_PLAIN = 0, EM_SILU = 1, EM_ROPE = 2 };
template <int MODE>
__device__ __forceinline__ void epi_rows(const f32x4 (&acc)[2][2][4][2], int bj, bf16_t* dst, int pitch, int row0, int fq, float scale_unused, const f32x2* rope_m0  ) {
#pragma unroll
    for (int ai = 0; ai < 2; ++ai)
#pragma unroll
        for (int m = 0; m < 4; ++m) {
            const int row = row0 + ai * HALF + m * 16;
            f32x4 v0 = acc[ai][bj][m][0], v1 = acc[ai][bj][m][1];
            if (MODE == EM_SILU) {
#pragma unroll
                for (int e = 0; e < 4; ++e) { v0[e] = silu_f(v0[e]); v1[e] = silu_f(v1[e]); }
            }
            if (MODE == EM_ROPE) {
                const f32x2* cs = rope_m0 + (row & 4095) * 32;
                const f32x2 c0_ = cs[0], c1_ = cs[1], c2_ = cs[2], c3_ = cs[3];
                f32x4 r0, r1;
                r0[0] = v0[0] * c0_.x - v0[1] * c0_.y; r0[1] = v0[1] * c0_.x + v0[0] * c0_.y;
                r0[2] = v0[2] * c1_.x - v0[3] * c1_.y; r0[3] = v0[3] * c1_.x + v0[2] * c1_.y;
                r1[0] = v1[0] * c2_.x - v1[1] * c2_.y; r1[1] = v1[1] * c2_.x + v1[0] * c2_.y;
                r1[2] = v1[2] * c3_.x - v1[3] * c3_.y; r1[3] = v1[3] * c3_.x + v1[2] * c3_.y;
                v0 = r0; v1 = r1;
            }
            *(u32x4*)(dst + (size_t)row * pitch + 8 * fq) = pack8bf(v0, v1);
        }
}
template <int NBJ>
__device__ __forceinline__ void epi_ss(const f32x4 (&acc)[2][2][4][2], float* ss, int stride, int slot, int row0, int fq) {
#pragma unroll
    for (int ai = 0; ai < 2; ++ai)
#pragma unroll
        for (int m = 0; m < 4; ++m) {
            float s = 0.f;
#pragma unroll
            for (int bj = 0; bj < NBJ; ++bj) { const f32x4 v0 = acc[ai][bj][m][0], v1 = acc[ai][bj][m][1];
                s += (v0[0] * v0[0] + v0[1] * v0[1]) + (v0[2] * v0[2] + v0[3] * v0[3]) + (v1[0] * v1[0] + v1[1] * v1[1]) + (v1[2] * v1[2] + v1[3] * v1[3]); }
            s += __shfl_xor(s, 16); s += __shfl_xor(s, 32);
            if (fq == 0) ss[(size_t)(row0 + ai * HALF + m * 16) * stride + slot] = s;
        }
}
struct EpiIn {
    static constexpr bool PERM = true, AFTER_DRAIN = false;
    unsigned char* ws;
    __device__ __forceinline__ void operator()(const f32x4 (&acc)[2][2][4][2], const Unit& u, int wr, int wc, int fr, int fq) const {
        const int pn = u.pn;
        const int row0 = u.pm * BM + wr * 64 + fr;
        const int cw = wc * 32;
        if (pn >= 26) {
            bf16_t* d = (bf16_t*)(ws + OFF_MIXED) + (pn - 26) * 256 + cw;
            epi_rows<EM_SILU>(acc, 0, d, 2048, row0, fq, 0.f, nullptr); epi_rows<EM_SILU>(acc, 1, d + HALF, 2048, row0, fq, 0.f, nullptr);
        } else if (pn >= 8) {
            bf16_t* d = (bf16_t*)(ws + OFF_QKV) + (size_t)((pn - 8) >> 1) * (16384 * 512) + ((pn - 8) & 1) * 256 + cw;
            epi_rows<EM_PLAIN>(acc, 0, d, 512, row0, fq, 0.f, nullptr); epi_rows<EM_PLAIN>(acc, 1, d + HALF, 512, row0, fq, 0.f, nullptr);
        } else if (pn >= 4) {
            bf16_t* d = (bf16_t*)(ws + OFF_IDXQ) + (pn - 4) * 256 + cw;
            epi_rows<EM_PLAIN>(acc, 0, d, 1024, row0, fq, 0.f, nullptr); epi_rows<EM_PLAIN>(acc, 1, d + HALF, 1024, row0, fq, 0.f, nullptr);
        } else if (pn == 0) {
            bf16_t* d = (bf16_t*)(ws + OFF_CKV) + cw;
            epi_rows<EM_PLAIN>(acc, 0, d, 256, row0, fq, 0.f, nullptr); epi_rows<EM_PLAIN>(acc, 1, d + HALF, 256, row0, fq, 0.f, nullptr);
            epi_ss<2>(acc, (float*)(ws + OFF_SSKV), 4, wc, row0, fq);
        } else if (pn == 1) {
            bf16_t* d = (bf16_t*)(ws + OFF_CQ) + cw;
            epi_rows<EM_PLAIN>(acc, 0, d, 384, row0, fq, 0.f, nullptr); epi_rows<EM_PLAIN>(acc, 1, d + HALF, 384, row0, fq, 0.f, nullptr);
            epi_ss<2>(acc, (float*)(ws + OFF_SSQ), 8, wc, row0, fq);
        } else if (pn == 2) {
            epi_rows<EM_PLAIN>(acc, 0, (bf16_t*)(ws + OFF_CQ) + 256 + cw, 384, row0, fq, 0.f, nullptr);
            epi_ss<1>(acc, (float*)(ws + OFF_SSQ), 8, 4 + wc, row0, fq);
            if (wc < 2) epi_rows<EM_ROPE>(acc, 1, (bf16_t*)(ws + OFF_KR) + cw, 64, row0, fq, 0.f, (const f32x2*)(ws + OFF_ROPE) + 16 * wc + 4 * fq);
            else        epi_rows<EM_PLAIN>(acc, 1, (bf16_t*)(ws + OFF_IDXK) + (cw - 64), 64, row0, fq, 0.f, nullptr);
        } else {
            if (wc == 0 && fq < 2) {
                float* d = (float*)(ws + OFF_IDXW) + 8 * fq;
#pragma unroll
                for (int ai = 0; ai < 2; ++ai)
#pragma unroll
                    for (int m = 0; m < 4; ++m) { float* p = d + (size_t)(row0 + ai * HALF + m * 16) * 16; *(f32x4*)p = acc[ai][0][m][0] * 0.03125f; *(f32x4*)(p + 4) = acc[ai][0][m][1] * 0.03125f; }
            }
        }
    }
};

struct EpiTail {
    static constexpr bool PERM = true, AFTER_DRAIN = false;
    unsigned char* ws;
    __device__ __forceinline__ void operator()(const f32x4 (&acc)[2][2][4][2], const Unit& u, int wr, int wc, int fr, int fq) const {
        const int row0 = u.pm * BM + u.hs * HALF + wr * 64 + fr;
        bf16_t* d = (bf16_t*)(ws + OFF_MIXED) + (u.pn - 26) * 256 + wc * 32;
#pragma unroll
        for (int bj = 0; bj < 2; ++bj)
#pragma unroll
            for (int m = 0; m < 4; ++m) {
                f32x4 v0 = acc[0][bj][m][0], v1 = acc[0][bj][m][1];
#pragma unroll
                for (int e = 0; e < 4; ++e) { v0[e] = silu_f(v0[e]); v1[e] = silu_f(v1[e]); }
                *(u32x4*)(d + bj * HALF + (size_t)(row0 + m * 16) * 2048 + 8 * fq) = pack8bf(v0, v1);
            }
    }
};

struct EpiQ {
    static constexpr bool PERM = true, AFTER_DRAIN = false;
    unsigned char* ws;
    __device__ __forceinline__ void operator()(const f32x4 (&acc)[2][2][4][2], const Unit& u, int wr, int wc, int fr, int fq) const {
        bf16_t* const QA = (bf16_t*)(ws + OFF_QA); const float* const SSQ = (const float*)(ws + OFF_SSQ);
        const int row0 = u.pm * BM + wr * 64 + fr;
        const int cb0 = u.pn * BM + wc * 32, cb1 = cb0 + HALF;
        const int ib0 = cb0 % 192, ib1 = cb1 % 192;
        const bool rp0 = ib0 >= 128, rp1 = ib1 >= 128;
        const f32x2* const rt0 = (const f32x2*)(ws + OFF_ROPE) + ((ib0 - 128) >> 1) + 4 * fq;
        const f32x2* const rt1 = (const f32x2*)(ws + OFF_ROPE) + ((ib1 - 128) >> 1) + 4 * fq;
#pragma unroll
        for (int ai = 0; ai < 2; ++ai)
#pragma unroll
            for (int m = 0; m < 4; ++m) {
                const int row = row0 + ai * HALF + m * 16;
                const f32x4 sa = *(const f32x4*)(SSQ + (size_t)row * 8), sb = *(const f32x4*)(SSQ + (size_t)row * 8 + 4);
                const float rs = __builtin_amdgcn_rsqf((((sa[0] + sa[1]) + (sa[2] + sa[3])) + ((sb[0] + sb[1]) + (sb[2] + sb[3]))) * (1.0f / 384.0f) + 1e-6f);
#pragma unroll
                for (int bj = 0; bj < 2; ++bj) {
                    f32x4 v0 = acc[ai][bj][m][0] * rs, v1 = acc[ai][bj][m][1] * rs;
                    if (bj == 0 ? rp0 : rp1) {
                        const f32x2* cs = (bj == 0 ? rt0 : rt1) + (row & 4095) * 32;
                        const f32x2 c0_ = cs[0], c1_ = cs[1], c2_ = cs[2], c3_ = cs[3];
                        f32x4 r0, r1;
                        r0[0] = v0[0] * c0_.x - v0[1] * c0_.y; r0[1] = v0[1] * c0_.x + v0[0] * c0_.y;
                        r0[2] = v0[2] * c1_.x - v0[3] * c1_.y; r0[3] = v0[3] * c1_.x + v0[2] * c1_.y;
                        r1[0] = v1[0] * c2_.x - v1[1] * c2_.y; r1[1] = v1[1] * c2_.x + v1[0] * c2_.y;
                        r1[2] = v1[2] * c3_.x - v1[3] * c3_.y; r1[3] = v1[3] * c3_.x + v1[2] * c3_.y;
                        v0 = r0; v1 = r1;
                    }
                    *(u32x4*)(QA + (size_t)row * 768 + (bj == 0 ? cb0 : cb1) + 8 * fq) = pack8bf(v0, v1);
                }
            }
    }
};
struct EpiKV {
    static constexpr bool PERM = true, AFTER_DRAIN = false;
    unsigned char* ws;
    __device__ __forceinline__ void operator()(const f32x4 (&acc)[2][2][4][2], const Unit& u, int wr, int wc, int fr, int fq) const {
        bf16_t* const KVA = (bf16_t*)(ws + OFF_KVA); const float* const SSKV = (const float*)(ws + OFF_SSKV);
        const int row0 = u.pm * BM + wr * 64 + fr;
#pragma unroll
        for (int ai = 0; ai < 2; ++ai)
#pragma unroll
            for (int m = 0; m < 4; ++m) {
                const int row = row0 + ai * HALF + m * 16;
                const f32x4 sa = *(const f32x4*)(SSKV + (size_t)row * 4);
                const float rs = __builtin_amdgcn_rsqf(((sa[0] + sa[1]) + (sa[2] + sa[3])) * (1.0f / 256.0f) + 1e-6f);
#pragma unroll
                for (int bj = 0; bj < 2; ++bj) {
                    const int c0 = u.pn * BM + bj * HALF + wc * 32 + 8 * fq;
                    *(u32x4*)(KVA + (size_t)row * 1024 + c0) = pack8bf(acc[ai][bj][m][0] * rs, acc[ai][bj][m][1] * rs);
                }
            }
    }
};
struct EpiY {
    static constexpr bool PERM = true, AFTER_DRAIN = false;
    unsigned char* ws;
    __device__ __forceinline__ void operator()(const f32x4 (&acc)[2][2][4][2], const Unit& u, int wr, int wc, int fr, int fq) const {
        bf16_t* d = (bf16_t*)(ws + OFF_Y) + u.pn * BM + wc * 32;
        const int row0 = u.pm * BM + wr * 64 + fr;
        epi_rows<EM_PLAIN>(acc, 0, d, 2048, row0, fq, 0.f, nullptr); epi_rows<EM_PLAIN>(acc, 1, d + HALF, 2048, row0, fq, 0.f, nullptr);
    }
};
template <class Epi, class Sched, bool ALIGN_EPI = false, bool SP2 = false, bool HALFM = false>
__device__ __forceinline__ void gemm_phase(PG8_LAS unsigned char* lds, const Gemm g, const Sched& S, const Epi& E, int wave_in  ) {
    int tid_ = wave_in * 64 + fresh_lane(); asm volatile("" : "+v"(tid_));
    const int tid = tid_, wid = __builtin_amdgcn_readfirstlane(tid >> 6), lane = tid & 63, wr = wid >> 2, wc = wid & 3, fr = lane & 15, fq = lane >> 4;
    int K_ = g.K; asm volatile("" : "+s"(K_));
    const int K = K_, nt = K / BK;
    unsigned voffA[2], voffB[2];
#pragma unroll
    for (int i = 0; i < 2; ++i) { int R, C; stage_rc(tid * 16 + i * 8192, R, C); const int Rb = Epi::PERM ? ((R & ~31) + perm32(R & 31)) : R;
        voffA[i] = (unsigned)(R * K + C) * 2u; voffB[i] = (unsigned)(Rb * K + C) * 2u; }
    const size_t kstep = (size_t)(BK * 2);
    const size_t hstep = (size_t)HALF * K * 2;
    const size_t tstep = 2 * hstep;
    const size_t hstepA = HALFM ? (size_t)0 : hstep;
    static_assert(!HALFM || SP2, "HALFM needs the SP2 loop");
    const unsigned ldsw = (unsigned)wid * 1024u;
    const int aoff = lds_byte(wr * 64 + fr, fq * 8), boff = lds_byte(wc * 32 + fr, fq * 8);
#define PG8_SA(b, h) (((b) * 2 + (h)) * HTB)
#define PG8_SB(b, h) ((4 + (b) * 2 + (h)) * HTB)
#define PG8_STAGE(bufoff, gbase, voff) do { _Pragma("unroll") for (int _i = 0; _i < 2; ++_i) \
        __builtin_amdgcn_global_load_lds((const unsigned*)((const char*)(gbase) + (voff)[_i]), (PG8_LAS unsigned*)(lds + (bufoff) + ldsw + _i * 8192), 16, 0, 0); } while (0)
#define PG8_LDA(dst, b, h) do { _Pragma("unroll") for (int m = 0; m < 4; ++m) _Pragma("unroll") for (int k = 0; k < 2; ++k) dst[m][k] = *(const PG8_LAS bf16x8*)(lds + PG8_SA(b, h) + aoff + m * 2048 + k * 1024); } while (0)
#define PG8_LDB(dst, b, h) do { _Pragma("unroll") for (int n = 0; n < 2; ++n) _Pragma("unroll") for (int k = 0; k < 2; ++k) dst[n][k] = *(const PG8_LAS bf16x8*)(lds + PG8_SB(b, h) + boff + n * 2048 + k * 1024); } while (0)
#define PG8_MMA(ai, bj, At, Bt) do { __builtin_amdgcn_s_setprio(1); _Pragma("unroll") for (int m = 0; m < 4; ++m) _Pragma("unroll") for (int n = 0; n < 2; ++n) _Pragma("unroll") for (int k = 0; k < 2; ++k) \
        acc[ai][bj][m][n] = __builtin_amdgcn_mfma_f32_16x16x32_bf16(Bt[n][k], At[m][k], acc[ai][bj][m][n], 0, 0, 0); __builtin_amdgcn_s_setprio(0); } while (0)
#define PG8_WAIT_V(n) asm volatile("s_waitcnt vmcnt(" #n ")" ::: "memory")
#define PG8_WAIT_L(n) asm volatile("s_waitcnt lgkmcnt(" #n ")" ::: "memory")
#define PG8_BAR __builtin_amdgcn_s_barrier()
#define PG8_SCHED __builtin_amdgcn_sched_barrier(0)
    Unit cur, nxt; int ui = 0;
    if (!S.next(0, cur)) return;
    f32x4 acc[2][2][4][2];
#pragma unroll
    for (int a = 0; a < 2; ++a)
#pragma unroll
        for (int b = 0; b < 2; ++b)
#pragma unroll
            for (int m = 0; m < 4; ++m)
#pragma unroll
                for (int n = 0; n < 2; ++n) acc[a][b][m][n] = (f32x4){0.f, 0.f, 0.f, 0.f};
    bf16x8 At[4][2], B0[2][2], B1[2][2];
    const char* cA = (const char*)g.A + (size_t)cur.pm * tstep + (HALFM ? (size_t)cur.hs * hstep : (size_t)0); const char* cB = (const char*)g.Bt + (size_t)cur.pn * tstep;
    S.a_ready(cur);
    if constexpr (SP2) {
        PG8_STAGE(PG8_SB(0, 0), cB, voffB); PG8_STAGE(PG8_SB(0, 1), cB + hstep, voffB); PG8_STAGE(PG8_SA(0, 0), cA, voffA); PG8_STAGE(PG8_SA(0, 1), cA + hstepA, voffA);
        if (wr == 1) PG8_BAR;
        PG8_WAIT_V(2); PG8_BAR;
        PG8_STAGE(PG8_SB(1, 0), cB + kstep, voffB); PG8_STAGE(PG8_SA(1, 0), cA + kstep, voffA); PG8_STAGE(PG8_SB(1, 1), cB + hstep + kstep, voffB);
        PG8_WAIT_V(6); PG8_BAR;
    } else {
        PG8_STAGE(PG8_SB(0, 0), cB, voffB); PG8_STAGE(PG8_SA(0, 0), cA, voffA); PG8_STAGE(PG8_SB(0, 1), cB + hstep, voffB); PG8_STAGE(PG8_SA(0, 1), cA + hstep, voffA);
        if (wr == 1) PG8_BAR;
        PG8_WAIT_V(4); PG8_BAR;
        PG8_STAGE(PG8_SB(1, 0), cB + kstep, voffB); PG8_STAGE(PG8_SA(1, 0), cA + kstep, voffA); PG8_STAGE(PG8_SB(1, 1), cB + hstep + kstep, voffB);
        PG8_WAIT_V(6); PG8_BAR;
    }
    for (;;) {
        const bool has_next = S.next(ui + 1, nxt);
        const char* nA = has_next ? (const char*)g.A + (size_t)nxt.pm * tstep + (HALFM ? (size_t)nxt.hs * hstep : (size_t)0) : cA; const char* nB = has_next ? (const char*)g.Bt + (size_t)nxt.pn * tstep : cB;
        for (int t = 0; t < nt; t += 2) {
            const bool last = (t == nt - 2);
            const char* a1 = cA + (size_t)(t + 1) * kstep;
            const char* a2 = last ? nA : cA + (size_t)(t + 2) * kstep; const char* b2 = last ? nB : cB + (size_t)(t + 2) * kstep;
            const char* a3 = a2 + kstep; const char* b3 = b2 + kstep;
            if (last && has_next) S.a_ready(nxt);
            if constexpr (SP2) {
            PG8_LDB(B0, 0, 0); PG8_LDB(B1, 0, 1); PG8_SCHED; PG8_LDA(At, 0, 0); PG8_STAGE(PG8_SA(1, 1), a1 + hstepA, voffA);
            PG8_WAIT_V(8); PG8_WAIT_L(0); PG8_BAR; PG8_MMA(0, 0, At, B0); PG8_MMA(0, 1, At, B1); PG8_BAR; PG8_SCHED;
            if constexpr (!HALFM) PG8_LDA(At, 0, 1); PG8_STAGE(PG8_SB(0, 0), b2, voffB); PG8_STAGE(PG8_SB(0, 1), b2 + hstep, voffB); PG8_STAGE(PG8_SA(0, 0), a2, voffA);
            PG8_WAIT_V(8); PG8_WAIT_L(0); PG8_BAR; if constexpr (!HALFM) { PG8_MMA(1, 0, At, B0); PG8_MMA(1, 1, At, B1); } PG8_BAR; PG8_SCHED;
            PG8_LDB(B0, 1, 0); PG8_LDB(B1, 1, 1); PG8_SCHED; PG8_LDA(At, 1, 0); PG8_STAGE(PG8_SA(0, 1), a2 + hstepA, voffA);
            PG8_WAIT_V(8); PG8_WAIT_L(0); PG8_BAR; PG8_MMA(0, 0, At, B0); PG8_MMA(0, 1, At, B1); PG8_BAR; PG8_SCHED;
            if constexpr (!HALFM) PG8_LDA(At, 1, 1); PG8_STAGE(PG8_SB(1, 0), b3, voffB); PG8_STAGE(PG8_SB(1, 1), b3 + hstep, voffB); PG8_STAGE(PG8_SA(1, 0), a3, voffA);
            PG8_WAIT_V(8); PG8_WAIT_L(0); PG8_BAR; if constexpr (!HALFM) { PG8_MMA(1, 0, At, B0); PG8_MMA(1, 1, At, B1); } PG8_BAR; PG8_SCHED;
            } else {
            PG8_LDB(B0, 0, 0); PG8_SCHED; PG8_LDA(At, 0, 0); PG8_STAGE(PG8_SA(1, 1), a1 + hstep, voffA);
            PG8_WAIT_L(8); PG8_BAR; PG8_WAIT_L(0); PG8_MMA(0, 0, At, B0); PG8_BAR; PG8_SCHED;
            PG8_LDB(B1, 0, 1); PG8_STAGE(PG8_SB(0, 0), b2, voffB);
            PG8_BAR; PG8_WAIT_L(0); PG8_MMA(0, 1, At, B1); PG8_BAR;
            PG8_LDA(At, 0, 1); PG8_STAGE(PG8_SA(0, 0), a2, voffA);
            PG8_BAR; PG8_WAIT_L(0); PG8_MMA(1, 0, At, B0); PG8_BAR; PG8_SCHED;
            PG8_STAGE(PG8_SB(0, 1), b2 + hstep, voffB);
            PG8_WAIT_V(6); PG8_BAR; PG8_MMA(1, 1, At, B1); PG8_BAR;
            PG8_LDB(B0, 1, 0); PG8_SCHED; PG8_LDA(At, 1, 0); PG8_STAGE(PG8_SA(0, 1), a2 + hstep, voffA);
            PG8_WAIT_L(8); PG8_BAR; PG8_WAIT_L(0); PG8_MMA(0, 0, At, B0); PG8_BAR; PG8_SCHED;
            PG8_LDB(B1, 1, 1); PG8_STAGE(PG8_SB(1, 0), b3, voffB);
            PG8_BAR; PG8_WAIT_L(0); PG8_MMA(0, 1, At, B1); PG8_BAR;
            PG8_LDA(At, 1, 1); PG8_STAGE(PG8_SA(1, 0), a3, voffA);
            PG8_BAR; PG8_WAIT_L(0); PG8_MMA(1, 0, At, B0); PG8_BAR; PG8_SCHED;
            PG8_STAGE(PG8_SB(1, 1), b3 + hstep, voffB);
            PG8_WAIT_V(6); PG8_BAR; PG8_MMA(1, 1, At, B1); PG8_BAR;
            }
        }
        if constexpr (ALIGN_EPI) { if (wr == 0) PG8_BAR; }
        if constexpr (!Epi::AFTER_DRAIN) { E(acc, cur, wr, wc, fr, fq); S.done(cur); }
        if (!has_next) break;
#pragma unroll
        for (int a = 0; a < 2; ++a)
#pragma unroll
            for (int b = 0; b < 2; ++b)
#pragma unroll
                for (int m = 0; m < 4; ++m)
#pragma unroll
                    for (int n = 0; n < 2; ++n) acc[a][b][m][n] = (f32x4){0.f, 0.f, 0.f, 0.f};
        cur = nxt; cA = nA; cB = nB; ++ui;
        if constexpr (ALIGN_EPI) { if (wr == 1) PG8_BAR; }
    }
    PG8_WAIT_V(0);
    if constexpr (!ALIGN_EPI) { if (wr == 0) PG8_BAR; }
    PG8_BAR;
    if constexpr (Epi::AFTER_DRAIN) { E.fused(acc, cur, wr, wc, fr, fq, lds, wid, lane); S.done(cur); }
#undef PG8_SA
#undef PG8_SB
#undef PG8_STAGE
#undef PG8_LDA
#undef PG8_LDB
#undef PG8_MMA
#undef PG8_WAIT_V
#undef PG8_WAIT_L
#undef PG8_BAR
#undef PG8_SCHED
}
}
#define XB_TMO      128
#define XB_XCNT(j)  (256  + 64 * (j))
#define XB_XSUB(j)  (1280 + 64 * (j))
#define XB_XGEN(j)  (2304 + 64 * (j))
#define XB_TOP      3328
#define XB_TOPGEN   3392
#define XCD_BAR_WORDS 3456
#define XB_SPIN_CAP (1u << 18)
#define LAS __attribute__((address_space(3)))

__device__ __forceinline__ unsigned xb_ld(unsigned* p)              { return __hip_atomic_load(p, __ATOMIC_RELAXED, __HIP_MEMORY_SCOPE_AGENT); }
__device__ __forceinline__ unsigned xb_add(unsigned* p, unsigned v) { return __hip_atomic_fetch_add(p, v, __ATOMIC_RELAXED, __HIP_MEMORY_SCOPE_AGENT); }
__device__ __forceinline__ unsigned xb_xcc_id() { return (unsigned)__builtin_amdgcn_s_getreg((3 << 11) | 20) & 0xFu; }
#define XB_SPIN(cond, bar) do { unsigned _sp = 0; while (cond) { __builtin_amdgcn_s_sleep(1); \
    if ((++_sp & 255u) == 0u) { if (xb_ld(&(bar)[XB_TMO])) break; if (_sp > XB_SPIN_CAP) { atomicAdd(&(bar)[XB_TMO], 1u); break; } } } } while (0)

struct XcdBarrier {
    int wave0;
    unsigned* bar; unsigned x;
    volatile LAS unsigned* st;
};

__device__ __forceinline__ XcdBarrier xcd_barrier_post(unsigned* bar, volatile LAS unsigned* st) {
    XcdBarrier b; b.bar = bar; b.x = xb_xcc_id(); b.st = st;
    if (threadIdx.x == 0) (void)xb_add(&bar[XB_XCNT(b.x)], 1u);
    return b;
}
__device__ __forceinline__ void xcd_barrier_complete(unsigned* bar, unsigned x, unsigned& nloc, unsigned& nx) {
    const unsigned G = gridDim.x * gridDim.y * gridDim.z;
    unsigned sum, cnt, mine, sp = 0u;
    for (;;) {
        sum = 0u; cnt = 0u; mine = 0u;
#pragma unroll
        for (unsigned j = 0; j < 16; ++j) { const unsigned c = xb_ld(&bar[XB_XCNT(j)]); sum += c; cnt += (c > 0u) ? 1u : 0u; mine = (j == x) ? c : mine; }
        if (sum == G) break;
        __builtin_amdgcn_s_sleep(1);
        if ((++sp & 255u) == 0u) { if (xb_ld(&bar[XB_TMO])) break; if (sp > XB_SPIN_CAP) { atomicAdd(&bar[XB_TMO], 1u); break; } }
    }
    nloc = mine > 0u ? mine : 1u; nx = cnt > 0u ? cnt : 1u;
}

__device__ __forceinline__ void xcd_barrier(const XcdBarrier& b) {
    asm volatile("s_waitcnt vmcnt(0)" ::: "memory");
    __syncthreads();
    if (b.wave0 == 0 && fresh_lane() == 0) {
        unsigned* bar = b.bar;
        __builtin_amdgcn_s_waitcnt(0);
        unsigned nloc = b.st[0], nx = b.st[1];
        if (nloc == 0u) { xcd_barrier_complete(bar, b.x, nloc, nx); b.st[0] = nloc; b.st[1] = nx; }
        const unsigned old = xb_add(&bar[XB_XSUB(b.x)], 1u);
        const unsigned gen = old / nloc;
        if (old + 1u == (gen + 1u) * nloc) {
            __builtin_amdgcn_fence(__ATOMIC_RELEASE, "agent");
            asm volatile("s_waitcnt vmcnt(0)" ::: "memory");
            const unsigned og = xb_add(&bar[XB_TOP], 1u);
            const unsigned tg = og / nx;
            if (og + 1u == (tg + 1u) * nx) xb_add(&bar[XB_TOPGEN], 1u);
            else XB_SPIN(xb_ld(&bar[XB_TOPGEN]) == tg, bar);
            __builtin_amdgcn_fence(__ATOMIC_ACQUIRE, "agent");
            xb_add(&bar[XB_XGEN(b.x)], 1u);
            asm volatile("s_waitcnt vmcnt(0)" ::: "memory");
        } else {
            XB_SPIN(xb_ld(&bar[XB_XGEN(b.x)]) == gen, bar);
            __builtin_amdgcn_fence(__ATOMIC_ACQUIRE, "agent");
            asm volatile("s_waitcnt vmcnt(0)" ::: "memory");
        }
    }
    __syncthreads();
}

using pg8::bf16_t; using pg8::f32x4; using pg8::u32x4; using pg8::f32x2;
constexpr int SEQ = 4096, DM = 2048, INW = 8464;
constexpr float LOG2E = 1.4426950408889634f;
constexpr int NWAVES = 8;
constexpr int LDS_BYTES = 147456, MISC_OFF = LDS_BYTES - 256;
constexpr int N_PHASES = 12;

__constant__ float ROPE_INV[32] = {1.000000000e+00f, 7.498942614e-01f, 5.623413324e-01f, 4.216965139e-01f, 3.162277639e-01f, 2.371373773e-01f, 1.778279394e-01f, 1.333521307e-01f,
    1.000000015e-01f, 7.498941571e-02f, 5.623413250e-02f, 4.216965288e-02f, 3.162277490e-02f, 2.371373773e-02f, 1.778279431e-02f, 1.333521493e-02f,
    9.999999776e-03f, 7.498941850e-03f, 5.623413250e-03f, 4.216964822e-03f, 3.162277630e-03f, 2.371373586e-03f, 1.778279431e-03f, 1.333521446e-03f,
    1.000000047e-03f, 7.498942432e-04f, 5.623413017e-04f, 4.216965172e-04f, 3.162277571e-04f, 2.371373703e-04f, 1.778279402e-04f, 1.333521504e-04f};

struct Args { const float* in[18]; float* out; unsigned char* ws; int ph_lo, ph_hi; };
struct Frame {
    LAS unsigned char* lds; int wave, G, vcu;
    const Args* a; float* out; unsigned char* ws;
};
#define FIN(i) (F.a->in[i])
#define WSP(T, off) ((T*)(ws_l + (off)))
#define WS_LOCAL size_t wz_ = 0; int bid = (int)blockIdx.x, G_l = F.G; asm volatile("" : "+s"(wz_), "+s"(bid), "+s"(G_l)); unsigned char* const ws_l = F.ws + wz_; (void)bid; (void)G_l;
#define PHASE_LOCALS int lane_ = fresh_lane(); asm volatile("" : "+v"(lane_)); const int lane = lane_, wave = F.wave, tid = wave * 64 + lane; (void)tid; WS_LOCAL

__device__ __forceinline__ float bf_lo(unsigned w) { return __uint_as_float(w << 16); }
__device__ __forceinline__ float bf_hi(unsigned w) { return __uint_as_float(w & 0xffff0000u); }
__device__ __forceinline__ float wave_max(float v) { for (int o = 32; o; o >>= 1) v = fmaxf(v, __shfl_xor(v, o)); return v; }
__device__ __forceinline__ float wave_sum(float v) { for (int o = 32; o; o >>= 1) v += __shfl_xor(v, o); return v; }
#define LDS_WAVE_SYNC() asm volatile("s_waitcnt lgkmcnt(0)" ::: "memory")

__device__ __forceinline__ int t5_bucket(int n) {
    if (n < 16) return n;
    int b = 16;
    b += (n >= 22) + (n >= 30) + (n >= 40) + (n >= 54) + (n >= 73) + (n >= 99) + (n >= 134) + (n >= 182) + (n >= 246) + (n >= 332) + (n >= 450) + (n >= 609) + (n >= 825) + (n >= 1117) + (n >= 1513);
    return b;
}
__device__ __forceinline__ int src_in(int n) {
    if (n < 256) return 384 + n;
    if (n < 512) return n - 256;
    if (n < 640) return n - 256;
    if (n < 704) { const int t = n - 640; return 640 + ((t & 1) ? 32 + (t >> 1) : (t >> 1)); }
    if (n < 768) return 4800 + (n - 704);
    if (n < 784) return 4864 + (n - 768);
    if (n < 1024) return -1;
    if (n < 2048) return 3776 + (n - 1024);
    if (n < 3584) return 704 + (n - 2048);
    if (n < 5120) return 2240 + (n - 3584);
    if (n < 6656) return 4880 + (n - 5120);
    return 6416 + (n - 6656);
}
__device__ __forceinline__ int src_uq(int n) { const int h = n / 192, i = n % 192; if (i < 128) return n; const int t = i - 128; return h * 192 + 128 + ((t & 1) ? 32 + (t >> 1) : (t >> 1)); }

struct Src8 { int ia, ib, kind; };
__device__ __forceinline__ Src8 src8_of(int mat, int n0) {
    Src8 r; int c0 = n0; r.kind = 0;
    if (mat == 0) { if (n0 >= 640 && n0 < 704) { r.kind = 1; c0 = 640 + ((n0 - 640) >> 1); } else c0 = src_in(n0); }
    else if (mat == 2) { const int h = n0 / 192, i0 = n0 % 192; if (i0 >= 128) { r.kind = 1; c0 = h * 192 + 128 + ((i0 - 128) >> 1); } }
    if (c0 < 0) { r.kind = 2; c0 = 0; }
    r.ia = c0; r.ib = (r.kind == 1) ? c0 + 32 : c0 + 4;
    return r;
}
__device__ __forceinline__ void combine8(const Src8& s, const f32x4& a, const f32x4& b, float gk, float (&o)[8]) {
    if (s.kind == 1) { o[0] = a[0]; o[1] = b[0]; o[2] = a[1]; o[3] = b[1]; o[4] = a[2]; o[5] = b[2]; o[6] = a[3]; o[7] = b[3]; }
    else { o[0] = a[0]; o[1] = a[1]; o[2] = a[2]; o[3] = a[3]; o[4] = b[0]; o[5] = b[1]; o[6] = b[2]; o[7] = b[3]; }
#pragma unroll
    for (int e = 0; e < 8; ++e) o[e] = (s.kind == 2) ? 0.f : o[e] * gk;
}
struct WTile { int mat, nt, kt, K, ldsrc; const float* src; bf16_t* dst; const float* gain; };
__device__ __forceinline__ WTile wtile_of(const Frame& F, unsigned char* ws_l, int l, int v) {
    constexpr int U_IN = 136 * 32, U_OUT = 32 * 32, U_UQ = 12 * 6;
    WTile t; t.gain = nullptr;
    if (v < U_IN) { t.mat = 0; t.nt = v % 136; t.kt = v / 136; t.K = 2048; t.ldsrc = INW; t.src = FIN(6) + (size_t)l * 2048 * INW; t.dst = WSP(bf16_t, l == 0 ? WS_WTIN0 : WS_WTIN1); }
    else if ((v -= U_IN) < U_OUT) { t.mat = 1; t.nt = v & 31; t.kt = v >> 5; t.K = 2048; t.ldsrc = 2048; t.src = FIN(16) + (size_t)l * 2048 * 2048; t.dst = WSP(bf16_t, WS_WTOUT) + (size_t)l * 2048 * 2048; }
    else if ((v -= U_OUT) < U_UQ) { t.mat = 2; t.nt = v % 12; t.kt = v / 12; t.K = 384; t.ldsrc = 768; t.src = FIN(8) + (size_t)l * 384 * 768; t.dst = WSP(bf16_t, WS_WTUQ) + (size_t)l * 768 * 384; t.gain = FIN(7) + l * 384; }
    else { v -= U_UQ; t.mat = 3; t.nt = v & 15; t.kt = v >> 4; t.K = 256; t.ldsrc = 1024; t.src = FIN(10) + (size_t)l * 256 * 1024; t.dst = WSP(bf16_t, WS_WTUKV) + (size_t)l * 1024 * 256; t.gain = FIN(9) + l * 256; }
    return t;
}
__device__ __forceinline__ void convert_weights(const Frame& F, int l, int qidx) {
    PHASE_LOCALS
    LAS float* tiles = (LAS float*)F.lds;
    constexpr int U_L = 136 * 32 + 32 * 32 + 12 * 6 + 16 * 4, NB = 4, TSZ = 64 * 65;
    unsigned* qctr = (unsigned*)(ws_l + WS_CTL + 16384 + qidx * 256);
    volatile LAS unsigned* qslot = (volatile LAS unsigned*)(F.lds + MISC_OFF) + 16;
    if (tid == 0) { const unsigned q0_ = atomicAdd(qctr, (unsigned)NB), q1_ = atomicAdd(qctr, (unsigned)NB); qslot[0] = q0_; qslot[1] = q1_; }
    __syncthreads();
    int u0 = (int)qslot[0], u1 = (int)qslot[1];
    __syncthreads();
    const int k = tid >> 3, n8 = (tid & 7) * 8;
    WTile t[NB]; Src8 sd[NB]; f32x4 va[NB], vb[NB]; float gk[NB];
#define CW_LOAD(U) do { _Pragma("unroll") for (int i = 0; i < NB; ++i) { t[i] = wtile_of(F, ws_l, l, (U) + i); sd[i] = src8_of(t[i].mat, t[i].nt * 64 + n8); } \
        _Pragma("unroll") for (int i = 0; i < NB; ++i) { const float* srow = t[i].src + (size_t)(t[i].kt * 64 + k) * t[i].ldsrc; \
            va[i] = *(const f32x4*)(srow + sd[i].ia); vb[i] = *(const f32x4*)(srow + sd[i].ib); gk[i] = t[i].gain ? t[i].gain[t[i].kt * 64 + k] : 1.0f; } } while (0)
    if (u0 < U_L) CW_LOAD(u0);
    while (u0 < U_L) {
        unsigned u2 = 0u; if (tid == 0) u2 = atomicAdd(qctr, (unsigned)NB);
#pragma unroll
        for (int i = 0; i < NB; ++i) { float o[8]; combine8(sd[i], va[i], vb[i], gk[i], o);
#pragma unroll
            for (int e = 0; e < 8; ++e) tiles[i * TSZ + k * 65 + n8 + e] = o[e]; }
        bf16_t* dst[NB]; int dK[NB];
#pragma unroll
        for (int i = 0; i < NB; ++i) { dK[i] = t[i].K; dst[i] = t[i].dst + (size_t)(t[i].nt * 64) * t[i].K + t[i].kt * 64; }
        if (u1 < U_L) CW_LOAD(u1);
        __syncthreads();
        const int n = tid >> 3, k8 = (tid & 7) * 8;
#pragma unroll
        for (int i = 0; i < NB; ++i) {
            float v[8];
#pragma unroll
            for (int e = 0; e < 8; ++e) v[e] = tiles[i * TSZ + (k8 + e) * 65 + n];
            u32x4 w; w.x = pg8::cvt_pk_bf16(v[0], v[1]); w.y = pg8::cvt_pk_bf16(v[2], v[3]); w.z = pg8::cvt_pk_bf16(v[4], v[5]); w.w = pg8::cvt_pk_bf16(v[6], v[7]);
            *(u32x4*)(dst[i] + (size_t)n * dK[i] + k8) = w;
        }
        if (tid == 0) qslot[0] = u2;
        __syncthreads();
        u0 = u1; u1 = (int)qslot[0];
    }
#undef CW_LOAD
    __syncthreads();
}
__device__ __forceinline__ void p0_prologue(const Frame& F) {
    PHASE_LOCALS
    LAS float* tile = (LAS float*)F.lds;
    for (int it = bid; it < 192; it += G_l) {
        const int l = it / 96, n0 = (it % 96) * 64;
        LAS float* sc = tile;
        LAS float* part = tile + 8192;
        for (int i = tid; i < 8192; i += NWAVES * 64) sc[i] = pg8::silu_f(FIN(1)[i]);
        __syncthreads();
        const int kk = tid >> 4, c4 = (tid & 15) * 4;
        float acc[4][4];
#pragma unroll
        for (int i = 0; i < 4; ++i)
#pragma unroll
            for (int b = 0; b < 4; ++b) acc[i][b] = 0.f;
        const float* wp = FIN(2) + (size_t)l * 2048 * 6144 + n0 + c4;
#pragma unroll 8
        for (int k = kk; k < 2048; k += 32) {
            const f32x4 w = *(const f32x4*)(wp + (size_t)k * 6144);
#pragma unroll
            for (int b = 0; b < 4; ++b) { const float sv = sc[b * 2048 + k]; acc[0][b] += sv * w[0]; acc[1][b] += sv * w[1]; acc[2][b] += sv * w[2]; acc[3][b] += sv * w[3]; }
        }
#pragma unroll
        for (int i = 0; i < 4; ++i) *(LAS f32x4*)(part + (kk * 64 + c4 + i) * 4) = (f32x4){acc[i][0], acc[i][1], acc[i][2], acc[i][3]};
        __syncthreads();
        if (tid < 256) {
            const int n = tid >> 2, b = tid & 3;
            float sum = 0.f;
            for (int q = 0; q < 32; ++q) sum += part[(q * 64 + n) * 4 + b];
            WSP(float, WS_MOD)[(size_t)(l * 4 + b) * 6144 + n0 + n] = sum + FIN(3)[l * 6144 + n0 + n];
        }
        __syncthreads();
    }
    convert_weights(F, 0, 16);
    convert_weights(F, 1, 17);
    const int gt = bid * (NWAVES * 64) + tid, GT = G_l * NWAVES * 64;
    for (int i = gt; i < 4096 * 32; i += GT) {
        const int pos = i >> 5, f = i & 31;
        const float ang = (float)pos * ROPE_INV[f];
        const double x = (double)ang;
        const double q = __builtin_rint(x * 0.63661977236758134308);
        double r = __builtin_fma(-q, 1.57079632679489655800e+00, x); r = __builtin_fma(-q, 6.12323399573676603587e-17, r);
        const double r2 = r * r;
        const double sn = r * (1.0 + r2 * (-1.0 / 6 + r2 * (1.0 / 120 + r2 * (-1.0 / 5040 + r2 * (1.0 / 362880 + r2 * (-1.0 / 39916800 + r2 * (1.0 / 6227020800.0)))))));
        const double cn = 1.0 + r2 * (-0.5 + r2 * (1.0 / 24 + r2 * (-1.0 / 720 + r2 * (1.0 / 40320 + r2 * (-1.0 / 3628800 + r2 * (1.0 / 479001600.0))))));
        const int qi = (int)q & 3;
        const double s = (qi == 0) ? sn : (qi == 1) ? cn : (qi == 2) ? -sn : -cn;
        const double c = (qi == 0) ? cn : (qi == 1) ? -sn : (qi == 2) ? -cn : sn;
        f32x2 o; o.x = (float)c; o.y = (float)s; WSP(f32x2, WS_ROPE)[i] = o;
    }
    for (int i = gt; i < 8 * 4096; i += GT) { const int hh = i >> 12, d = i & 4095; WSP(float, WS_TCD)[i] = FIN(17)[t5_bucket(d) * 12 + 4 + hh] * LOG2E; }
    for (int i = gt; i < 3 * 4 * 192; i += GT) {
        const int g = i / 768, h = (i / 192) & 3, j = i % 192;
        const int dist = (g == 0 ? 1 : g == 1 ? 4 : 16) * (j > 128 ? 128 : j);
        WSP(float, WS_TB)[i] = FIN(17)[t5_bucket(dist) * 12 + h] * LOG2E;
    }
    if (gt < 2) {
        const int l = gt; float s1 = 0.f, s2 = 0.f;
        for (int i = 0; i < 64; ++i) { s1 += FIN(11)[l * 64 + i] * FIN(12)[l * 64 + i]; s2 += FIN(13)[l * 64 + i] * FIN(14)[l * 64 + i]; }
        const float li = (l == 0) ? 0.2f : 0.35550906759096926f;
        WSP(float, WS_CONST)[l] = expf(s1) - expf(s2) + li;
    }
}

#define DPP_ADD(v, ctrl) v += __builtin_bit_cast(float, __builtin_amdgcn_update_dpp(0, __builtin_bit_cast(int, v), ctrl, 0xF, 0xF, true))
__device__ __forceinline__ float wave_sum_v(float v) {
    DPP_ADD(v, 0xB1); DPP_ADD(v, 0x4E); DPP_ADD(v, 0x141); DPP_ADD(v, 0x140);
    { auto r = __builtin_amdgcn_permlane16_swap(__float_as_uint(v), __float_as_uint(v), false, false); v = __uint_as_float(r[0]) + __uint_as_float(r[1]); }
    { auto r = __builtin_amdgcn_permlane32_swap(__float_as_uint(v), __float_as_uint(v), false, false); v = __uint_as_float(r[0]) + __uint_as_float(r[1]); }
    return v;
}
constexpr int NV_A = 0, NV_B = 2048, NV_C = 4096;
__device__ __forceinline__ void lds8(const LAS float* p, float (&o)[8]) { const f32x4 a = *(const LAS f32x4*)p, b = *(const LAS f32x4*)(p + 4); o[0] = a[0]; o[1] = a[1]; o[2] = a[2]; o[3] = a[3]; o[4] = b[0]; o[5] = b[1]; o[6] = b[2]; o[7] = b[3]; }
__device__ __forceinline__ void store_h8(bf16_t* hp, const float (&v)[8], float rs, const LAS float* vb, const LAS float* vc) {
    float B[8], C[8]; lds8(vb, B); lds8(vc, C);
    float h[8];
#pragma unroll
    for (int e = 0; e < 8; ++e) h[e] = v[e] * rs * B[e] + C[e];
    u32x4 w; w.x = pg8::cvt_pk_bf16(h[0], h[1]); w.y = pg8::cvt_pk_bf16(h[2], h[3]); w.z = pg8::cvt_pk_bf16(h[4], h[5]); w.w = pg8::cvt_pk_bf16(h[6], h[7]);
    *(u32x4*)hp = w;
}
__device__ __forceinline__ void p_pre0(const Frame& F) {
    PHASE_LOCALS
    LAS float* vec = (LAS float*)F.lds;
    const float* mod = WSP(float, WS_MOD);
    for (int t = bid; t < M / 64; t += G_l) {
        const int b = t >> 6;
        __syncthreads();
        { const float* mb = mod + (size_t)(0 * 4 + b) * 6144; const float* gp = FIN(4);
          for (int c = tid; c < 2048; c += NWAVES * 64) { vec[NV_B + c] = gp[c] * (1.0f + mb[2048 + c]); vec[NV_C + c] = mb[c]; } }
        __syncthreads();
#pragma unroll 1
        for (int rp = 0; rp < 8; ++rp) {
            const int r0 = t * 64 + wave * 8 + rp;
            float xv[1][4][8];
#pragma unroll
            for (int q = 0; q < 1; ++q)
#pragma unroll
                for (int i = 0; i < 4; ++i) { const float* xp = FIN(0) + (size_t)(r0 + q) * DM + (i * 64 + lane) * 8; const f32x4 a = *(const f32x4*)xp, c = *(const f32x4*)(xp + 4);
                    xv[q][i][0] = a[0]; xv[q][i][1] = a[1]; xv[q][i][2] = a[2]; xv[q][i][3] = a[3]; xv[q][i][4] = c[0]; xv[q][i][5] = c[1]; xv[q][i][6] = c[2]; xv[q][i][7] = c[3]; }
#pragma unroll
            for (int q = 0; q < 1; ++q) {
                float ss = 0.f;
#pragma unroll
                for (int i = 0; i < 4; ++i)
#pragma unroll
                    for (int e = 0; e < 8; ++e) ss += xv[q][i][e] * xv[q][i][e];
                ss = wave_sum_v(ss);
                const float rs = __builtin_amdgcn_rsqf(ss * (1.0f / 2048.0f) + 1e-6f);
#pragma unroll
                for (int i = 0; i < 4; ++i) { const int c = (i * 64 + lane) * 8; store_h8(WSP(bf16_t, WS_H) + (size_t)(r0 + q) * DM + c, xv[q][i], rs, vec + NV_B + c, vec + NV_C + c); }
            }
        }
    }
    __syncthreads();
}
__device__ __forceinline__ void p_post(const Frame& F, int l) {
    PHASE_LOCALS
    LAS float* vec = (LAS float*)F.lds;
    const float* mod = WSP(float, WS_MOD);
    const bf16_t* Y = WSP(bf16_t, WS_Y);
    const float* xin = (l == 0) ? FIN(0) : F.out;
    for (int t = bid; t < M / 64; t += G_l) {
        const int b = t >> 6;
        __syncthreads();
        { const float* gate = mod + (size_t)(l * 4 + b) * 6144 + 4096; const float* gpo = FIN(5) + l * DM; const float* mb1 = mod + (size_t)(1 * 4 + b) * 6144; const float* gp1 = FIN(4) + DM;
          for (int c = tid; c < 2048; c += NWAVES * 64) { vec[NV_A + c] = gate[c] * gpo[c]; if (l == 0) { vec[NV_B + c] = gp1[c] * (1.0f + mb1[2048 + c]); vec[NV_C + c] = mb1[c]; } } }
        __syncthreads();
#pragma unroll 1
        for (int rp = 0; rp < 8; ++rp) {
            const int r0 = t * 64 + wave * 8 + rp;
            u32x4 yr[1][4]; float xv[1][4][8];
#pragma unroll
            for (int q = 0; q < 1; ++q)
#pragma unroll
                for (int i = 0; i < 4; ++i) { const size_t o = (size_t)(r0 + q) * DM + (i * 64 + lane) * 8; yr[q][i] = *(const u32x4*)(Y + o);
                    if (l == 0) { const f32x4 a = *(const f32x4*)(xin + o), c = *(const f32x4*)(xin + o + 4);
                        xv[q][i][0] = a[0]; xv[q][i][1] = a[1]; xv[q][i][2] = a[2]; xv[q][i][3] = a[3]; xv[q][i][4] = c[0]; xv[q][i][5] = c[1]; xv[q][i][6] = c[2]; xv[q][i][7] = c[3]; }
                    else {
                        const u32x4 w = *(const u32x4*)((const bf16_t*)(xin + (size_t)(r0 + q) * DM) + (i * 64 + lane) * 8);
                        xv[q][i][0] = bf_lo(w.x); xv[q][i][1] = bf_hi(w.x); xv[q][i][2] = bf_lo(w.y); xv[q][i][3] = bf_hi(w.y); xv[q][i][4] = bf_lo(w.z); xv[q][i][5] = bf_hi(w.z); xv[q][i][6] = bf_lo(w.w); xv[q][i][7] = bf_hi(w.w); } }
#pragma unroll
            for (int q = 0; q < 1; ++q) {
                float yv[4][8]; float ss = 0.f;
#pragma unroll
                for (int i = 0; i < 4; ++i) { const u32x4 w = yr[q][i];
                    yv[i][0] = bf_lo(w.x); yv[i][1] = bf_hi(w.x); yv[i][2] = bf_lo(w.y); yv[i][3] = bf_hi(w.y); yv[i][4] = bf_lo(w.z); yv[i][5] = bf_hi(w.z); yv[i][6] = bf_lo(w.w); yv[i][7] = bf_hi(w.w);
#pragma unroll
                    for (int e = 0; e < 8; ++e) ss += yv[i][e] * yv[i][e]; }
                ss = wave_sum_v(ss);
                const float rs = __builtin_amdgcn_rsqf(ss * (1.0f / 2048.0f) + 1e-6f);
                float ss2 = 0.f;
#pragma unroll
                for (int i = 0; i < 4; ++i) { const int c = (i * 64 + lane) * 8; float A[8]; lds8(vec + NV_A + c, A);
#pragma unroll
                    for (int e = 0; e < 8; ++e) { const float xn = xv[q][i][e] + A[e] * (yv[i][e] * rs); xv[q][i][e] = xn; ss2 += xn * xn; }
                    float* op = F.out + (size_t)(r0 + q) * DM + c;
                    if (l == 0) { u32x4 w; w.x = pg8::cvt_pk_bf16(xv[q][i][0], xv[q][i][1]); w.y = pg8::cvt_pk_bf16(xv[q][i][2], xv[q][i][3]); w.z = pg8::cvt_pk_bf16(xv[q][i][4], xv[q][i][5]); w.w = pg8::cvt_pk_bf16(xv[q][i][6], xv[q][i][7]);
                        *(u32x4*)((bf16_t*)(F.out + (size_t)(r0 + q) * DM) + c) = w; }
                    else { *(f32x4*)op = (f32x4){xv[q][i][0], xv[q][i][1], xv[q][i][2], xv[q][i][3]}; *(f32x4*)(op + 4) = (f32x4){xv[q][i][4], xv[q][i][5], xv[q][i][6], xv[q][i][7]}; } }
                if (l == 0) {
                    ss2 = wave_sum_v(ss2);
                    const float rs2 = __builtin_amdgcn_rsqf(ss2 * (1.0f / 2048.0f) + 1e-6f);
#pragma unroll
                    for (int i = 0; i < 4; ++i) { const int c = (i * 64 + lane) * 8; store_h8(WSP(bf16_t, WS_H) + (size_t)(r0 + q) * DM + c, xv[q][i], rs2, vec + NV_B + c, vec + NV_C + c); }
                }
            }
        }
    }
    __syncthreads();
}

__device__ __forceinline__ void p_gemm1(const Frame& F, int l) {
    WS_LOCAL
    pg8::Gemm g; g.A = WSP(bf16_t, WS_H); g.Bt = WSP(bf16_t, l == 0 ? WS_WTIN0 : WS_WTIN1); g.M = M; g.N = NW1; g.K = 2048;
    const bool full_grid = (G_l == 256);
    pg8::StaticOrder S; S.init(M, full_grid ? 32 * 256 : NW1, G_l, bid);
    pg8::EpiIn E; E.ws = ws_l;
    pg8::gemm_phase<pg8::EpiIn, pg8::StaticOrder, true, true>(F.lds, g, S, E, F.wave);
    if (full_grid) {
        pg8::TailOrder T; T.c = bid;
        pg8::EpiTail ET; ET.ws = ws_l;
        pg8::gemm_phase<pg8::EpiTail, pg8::TailOrder, true, true, true>(F.lds, g, T, ET, F.wave);
    }

}
__device__ __forceinline__ void p_upq(const Frame& F, int l) {
    WS_LOCAL
    pg8::Gemm g; g.A = WSP(bf16_t, WS_CQ); g.Bt = WSP(bf16_t, WS_WTUQ) + (size_t)l * 768 * 384; g.M = M; g.N = 768; g.K = 384;
    pg8::StaticOrder S; S.init(M, 768, G_l, bid);
    pg8::EpiQ E; E.ws = ws_l;
    pg8::gemm_phase<pg8::EpiQ, pg8::StaticOrder, true, true>(F.lds, g, S, E, F.wave);
}
__device__ __forceinline__ void p_upkv(const Frame& F, int l) {
    WS_LOCAL
    pg8::Gemm g; g.A = WSP(bf16_t, WS_CKV); g.Bt = WSP(bf16_t, WS_WTUKV) + (size_t)l * 1024 * 256; g.M = M; g.N = 1024; g.K = 256;
    pg8::StaticOrder S; S.init(M, 1024, G_l, bid);
    pg8::EpiKV E; E.ws = ws_l;
    pg8::gemm_phase<pg8::EpiKV, pg8::StaticOrder, true, true>(F.lds, g, S, E, F.wave);
}
__device__ __forceinline__ void p_gemm2(const Frame& F, int l) {
    WS_LOCAL
    pg8::Gemm g; g.A = WSP(bf16_t, WS_MIXED); g.Bt = WSP(bf16_t, WS_WTOUT) + (size_t)l * 2048 * 2048; g.M = M; g.N = 2048; g.K = 2048;
    pg8::StaticOrder S; S.init(M, 2048, G_l, bid);
    pg8::EpiY E; E.ws = ws_l;
    pg8::gemm_phase<pg8::EpiY, pg8::StaticOrder, true, true>(F.lds, g, S, E, F.wave);
}

__device__ __forceinline__ unsigned score_key(float x) { const unsigned b = __float_as_uint(x); return b ^ ((unsigned)((int)b >> 31) | 0x80000000u); }
__device__ __forceinline__ int wave_sum_i(int v) { for (int o = 32; o; o >>= 1) v += __shfl_xor(v, o); return v; }
extern "C" __device__ int llvm_writelane_i32(int, int, int) __asm("llvm.amdgcn.writelane.i32");
__device__ __forceinline__ unsigned wave_max_u(unsigned v) {
#define DPP_MAXU(v, ctrl) v = max(v, (unsigned)__builtin_amdgcn_update_dpp(0, (int)v, ctrl, 0xF, 0xF, true))
    DPP_MAXU(v, 0xB1); DPP_MAXU(v, 0x4E); DPP_MAXU(v, 0x141); DPP_MAXU(v, 0x140);
#undef DPP_MAXU
    const unsigned a = (unsigned)__builtin_amdgcn_readlane((int)v, 0), b = (unsigned)__builtin_amdgcn_readlane((int)v, 16), c = (unsigned)__builtin_amdgcn_readlane((int)v, 32), d = (unsigned)__builtin_amdgcn_readlane((int)v, 48);
    return max(max(a, b), max(c, d));
}
__device__ __forceinline__ bool select_row(const unsigned (&u)[64], int qpos, unsigned long long* mrow, int lane, LAS unsigned* cbuf  ) {
    unsigned long long myw = 0ull;
    if (qpos < 256) {
        const int lo = lane * 64;
        if (lo + 63 <= qpos) myw = ~0ull; else if (lo <= qpos) myw = (~0ull) >> (63 - (qpos - lo)); else myw = 0ull;
        mrow[lane] = myw; return true;
    }
    const int nj = (qpos >> 6) + 1;
    unsigned thr = 0u; bool exact = false;
    int lo_cnt = qpos + 1, hi_cnt = 0, bit = 31, scan = 6;
    unsigned P;
    {
        unsigned mx = 0u;
#pragma unroll
        for (int g = 0; g < 8; ++g) {
            if (8 * g < nj) {
#pragma unroll
                for (int q = 0; q < 8; ++q) mx = max(mx, u[8 * g + q]);
            }
        }
        P = wave_max_u(mx) >> 23;
    }
#pragma unroll 1
    for (;;) {
        if (scan == 0) { if (bit < 0 || lo_cnt - hi_cnt <= 64) break; }
        const unsigned cand = scan ? (P << 23) : (thr | (1u << bit));
        int cnt = 0;
#pragma unroll
        for (int g = 0; g < 8; ++g) {
            if (8 * g < nj) {
                unsigned long long m8[8];
#pragma unroll
                for (int q = 0; q < 8; ++q) m8[q] = __ballot(u[8 * g + q] >= cand);
                asm volatile("" :: "s"(m8[0]), "s"(m8[1]), "s"(m8[2]), "s"(m8[3]), "s"(m8[4]), "s"(m8[5]), "s"(m8[6]), "s"(m8[7]));
#pragma unroll
                for (int q = 0; q < 8; ++q) cnt += __popcll(m8[q]);
            }
        }
        if (scan) {
            if (cnt >= 256) { thr = cand; lo_cnt = cnt; bit = 22; scan = 0; if (cnt == 256) { exact = true; break; } }
            else { hi_cnt = cnt; --P; if (--scan == 0) { hi_cnt = 0; bit = 31; } }
        } else {
            if (cnt >= 256) { thr = cand; lo_cnt = cnt; if (cnt == 256) { exact = true; break; } } else hi_cnt = cnt;
            --bit;
        }
    }
    if (!exact && bit >= 0) {
        const unsigned tlo = thr ? thr : 1u;
        const unsigned span = ((bit == 31) ? 0xFFFFFFFFu : (thr + ((2u << bit) - 1u))) - tlo;
        unsigned base = 0u;
        cbuf[lane] = 0u;
#pragma unroll
        for (int g = 0; g < 8; ++g) {
            if (8 * g < nj) {
#pragma unroll
                for (int j = 8 * g; j < 8 * g + 8; ++j) {
                    const bool inb = (u[j] - tlo) <= span;
                    const unsigned long long m = __ballot(inb);
                    if (inb) cbuf[__builtin_amdgcn_mbcnt_hi((unsigned)(m >> 32), __builtin_amdgcn_mbcnt_lo((unsigned)m, base))] = u[j];
                    base += (unsigned)__popcll(m);
                }
            }
        }
        asm volatile("s_waitcnt lgkmcnt(0)" ::: "memory");
        const unsigned uc = cbuf[lane];
#pragma unroll 1
        for (; bit >= 0; --bit) {
            const unsigned cand = thr | (1u << bit);
            const int cnt = hi_cnt + __popcll(__ballot(uc >= cand));
            if (cnt >= 256) { thr = cand; if (cnt == 256) { exact = true; break; } }
        }
    }
    if (thr == 0u) return false;
    int wlo = 0, whi = 0;
    if (exact) {
#pragma unroll
        for (int g = 0; g < 8; ++g) {
            if (8 * g < nj) {
#pragma unroll
                for (int j = 8 * g; j < 8 * g + 8; ++j) { const unsigned long long m = __ballot(u[j] >= thr); wlo = llvm_writelane_i32((int)(unsigned)m, j, wlo); whi = llvm_writelane_i32((int)(unsigned)(m >> 32), j, whi); }
            }
        }
    } else {
        int cgt = 0;
#pragma unroll
        for (int j = 0; j < 64; ++j) cgt += __popcll(__ballot(u[j] > thr));
        int need = 256 - cgt;
#pragma unroll
        for (int j = 0; j < 64; ++j) {
            const unsigned long long gtm = __ballot(u[j] > thr); unsigned long long eqm = __ballot(u[j] == thr);
            int pc = __popcll(eqm);
            while (pc > need) { eqm &= ~(1ull << (63 - __clzll((long long)eqm))); --pc; }
            need -= pc;
            const unsigned long long m = gtm | eqm;
            wlo = llvm_writelane_i32((int)(unsigned)m, j, wlo); whi = llvm_writelane_i32((int)(unsigned)(m >> 32), j, whi);
        }
    }
    mrow[lane] = ((unsigned long long)(unsigned)whi << 32) | (unsigned long long)(unsigned)wlo;
    return true;
}
namespace fa {
typedef short bf16x8 __attribute__((ext_vector_type(8)));
typedef short s16x4 __attribute__((ext_vector_type(4)));
typedef float f32x16 __attribute__((ext_vector_type(16)));
constexpr int SHM_K = 16384, SHM_V = 16384, SHM_KR = 8192;
constexpr int NVB = 3;
constexpr int L_V = 0, L_K = NVB * SHM_V, L_KR = L_K + 2 * SHM_K, L_WS = L_KR + 2 * SHM_KR, L_TAB = L_WS + 8 * 256, TAB_N = 4416, L_END = L_TAB + TAB_N * 4;
static_assert(L_END <= 131072, "attention LDS map");
#define FA_KSWZ(row, colB) ((row) * 256 + ((colB) ^ (((row) & 7) << 4)))
#define FA_KRSWZ(row, colB) ((row) * 128 + ((colB) ^ (((row) & 7) << 4)))
#define FA_SBAR() __builtin_amdgcn_sched_barrier(0)
__device__ __forceinline__ int v_st(int k, int c) { const int kk = (k & ~0xC) | ((k & 4) << 1) | ((k & 8) >> 1); return ((kk >> 3) * 4 + (c >> 5)) * 512 + ((kk & 7) * 32 + (c & 31)) * 2; }
__device__ __forceinline__ int v_rd_base(int lane) { return ((lane & 3) << 3) | (((lane >> 2) & 3) << 6) | (((lane >> 4) & 1) << 5) | (((lane >> 5) & 1) << 8); }
constexpr int v_rd_off(int d0, int ks, int half) { return d0 * 512 + ks * 4096 + half * 2048; }
__device__ __forceinline__ int crow(int r, int hi) { return (r & 3) + 8 * (r >> 2) + 4 * hi; }
__device__ __forceinline__ unsigned cvtpk(float lo, float hi) { unsigned r; asm("v_cvt_pk_bf16_f32 %0, %1, %2" : "=v"(r) : "v"(lo), "v"(hi)); return r; }

#define FA_KRD(dst, addr, off) asm volatile("ds_read_b128 %0, %1 offset:%2" : "=&v"(dst) : "v"(addr), "i"(off) : "memory")
#define FA_LWAIT(n) do { asm volatile("s_waitcnt lgkmcnt(" #n ")" ::: "memory"); FA_SBAR(); } while (0)
template <int D0, int ND>
__device__ __forceinline__ void qkt_main(f32x16& p0, f32x16& p1, const LAS char* Kt, int r32, int hi, const bf16x8* qr) {
    unsigned kb[4];
#pragma unroll
    for (int dd = 0; dd < 4; ++dd) kb[dd] = (unsigned)(size_t)Kt + FA_KSWZ(r32, (dd * 16 + hi * 8) * 2);
    bf16x8 a0[2], a1[2];
#define FA_QRD(i) do { constexpr int d0_ = D0 + (i); FA_KRD(a0[(i) & 1], kb[d0_ & 3], (d0_ >> 2) * 128); FA_KRD(a1[(i) & 1], kb[d0_ & 3], (d0_ >> 2) * 128 + 32 * 256); } while (0)
#define FA_QMM(i) do { p0 = __builtin_amdgcn_mfma_f32_32x32x16_bf16(a0[(i) & 1], qr[i], p0, 0, 0, 0); p1 = __builtin_amdgcn_mfma_f32_32x32x16_bf16(a1[(i) & 1], qr[i], p1, 0, 0, 0); FA_SBAR(); } while (0)
    FA_QRD(0); FA_QRD(1);
    FA_LWAIT(2); FA_QMM(0); FA_QRD(2);
    FA_LWAIT(2); FA_QMM(1); FA_QRD(3);
    if constexpr (ND == 4) { FA_LWAIT(2); FA_QMM(2); FA_LWAIT(0); FA_QMM(3); }
    else {
        FA_LWAIT(2); FA_QMM(2); FA_QRD(4);
        FA_LWAIT(2); FA_QMM(3); FA_QRD(5);
        FA_LWAIT(2); FA_QMM(4); FA_QRD(6);
        FA_LWAIT(2); FA_QMM(5); FA_QRD(7);
        FA_LWAIT(2); FA_QMM(6); FA_LWAIT(0); FA_QMM(7);
    }
#undef FA_QMM
#undef FA_QRD
}
__device__ __forceinline__ void qkt_rope(f32x16& p0, f32x16& p1, const LAS char* Kt, int r32, int hi, const bf16x8* qr) {
    unsigned kb[4];
#pragma unroll
    for (int i = 0; i < 4; ++i) kb[i] = (unsigned)(size_t)Kt + FA_KRSWZ(r32, (i * 16 + hi * 8) * 2);
    bf16x8 a0[2], a1[2];
#define FA_QRD(i) do { FA_KRD(a0[(i) & 1], kb[i], 0); FA_KRD(a1[(i) & 1], kb[i], 32 * 128); } while (0)
#define FA_QMM(i) do { p0 = __builtin_amdgcn_mfma_f32_32x32x16_bf16(a0[(i) & 1], qr[i], p0, 0, 0, 0); p1 = __builtin_amdgcn_mfma_f32_32x32x16_bf16(a1[(i) & 1], qr[i], p1, 0, 0, 0); FA_SBAR(); } while (0)
    FA_QRD(0); FA_QRD(1);
    FA_LWAIT(2); FA_QMM(0); FA_QRD(2);
    FA_LWAIT(2); FA_QMM(1); FA_QRD(3);
    FA_LWAIT(2); FA_QMM(2); FA_LWAIT(0); FA_QMM(3);
#undef FA_QMM
#undef FA_QRD
}
__device__ __forceinline__ void pv_tile(f32x16* o, int vb0  , bf16x8 pa0, bf16x8 pa1, bf16x8 pa2, bf16x8 pa3) {
#define FA_TRRD(dst, off) asm volatile("ds_read_b64_tr_b16 %0, %1 offset:%2" : "=&v"(dst) : "v"(vb0), "i"(off) : "memory")
#define FA_RD8(S, ks) do { constexpr int b_ = v_rd_off(0, ks, 0); \
        FA_TRRD(S##l0, b_); FA_TRRD(S##h0, b_ + 2048); FA_TRRD(S##l1, b_ + 512); FA_TRRD(S##h1, b_ + 512 + 2048); FA_TRRD(S##l2, b_ + 1024); FA_TRRD(S##h2, b_ + 1024 + 2048); FA_TRRD(S##l3, b_ + 1536); FA_TRRD(S##h3, b_ + 1536 + 2048); } while (0)
#define FA_MM4(S, pa) do { \
        o[0] = __builtin_amdgcn_mfma_f32_32x32x16_bf16(pa, (bf16x8){S##l0[0], S##l0[1], S##l0[2], S##l0[3], S##h0[0], S##h0[1], S##h0[2], S##h0[3]}, o[0], 0, 0, 0);   \
        o[1] = __builtin_amdgcn_mfma_f32_32x32x16_bf16(pa, (bf16x8){S##l1[0], S##l1[1], S##l1[2], S##l1[3], S##h1[0], S##h1[1], S##h1[2], S##h1[3]}, o[1], 0, 0, 0);   \
        o[2] = __builtin_amdgcn_mfma_f32_32x32x16_bf16(pa, (bf16x8){S##l2[0], S##l2[1], S##l2[2], S##l2[3], S##h2[0], S##h2[1], S##h2[2], S##h2[3]}, o[2], 0, 0, 0);   \
        o[3] = __builtin_amdgcn_mfma_f32_32x32x16_bf16(pa, (bf16x8){S##l3[0], S##l3[1], S##l3[2], S##l3[3], S##h3[0], S##h3[1], S##h3[2], S##h3[3]}, o[3], 0, 0, 0); } while (0)
#define FA_WAITL(n) do { asm volatile("s_waitcnt lgkmcnt(" #n ")" ::: "memory"); FA_SBAR(); } while (0)
    s16x4 Al0, Al1, Al2, Al3, Ah0, Ah1, Ah2, Ah3, Bl0, Bl1, Bl2, Bl3, Bh0, Bh1, Bh2, Bh3;
    FA_RD8(A, 0); FA_RD8(B, 1);
    FA_WAITL(8); FA_MM4(A, pa0); FA_SBAR();
    FA_RD8(A, 2);
    FA_WAITL(8); FA_MM4(B, pa1); FA_SBAR();
    FA_RD8(B, 3);
    FA_WAITL(8); FA_MM4(A, pa2); FA_SBAR();
    FA_WAITL(0); FA_MM4(B, pa3);
#undef FA_WAITL
#undef FA_MM4
#undef FA_RD8
#undef FA_TRRD
}
__device__ __forceinline__ bool softmax_tile(f32x16& p0, f32x16& p1, float& m_reg, float& l_reg, float& alpha, bf16x8& pa0, bf16x8& pa1, bf16x8& pa2, bf16x8& pa3, float coff = 0.f) {
    float mx[8];
#pragma unroll
    for (int r = 0; r < 8; ++r) mx[r] = fmaxf(fmaxf(fmaxf(p0[r], p0[r + 8]), p1[r]), p1[r + 8]);
    float pmax = fmaxf(fmaxf(fmaxf(fmaxf(fmaxf(mx[0], mx[1]), mx[2]), fmaxf(fmaxf(mx[3], mx[4]), mx[5])), mx[6]), mx[7]);
    { auto rr = __builtin_amdgcn_permlane32_swap(__float_as_uint(pmax), __float_as_uint(pmax), false, false);
      pmax = fmaxf(__uint_as_float(rr[0]), __uint_as_float(rr[1])) + coff; }
    float mn; bool moved = false;
    if (__builtin_expect(__all((pmax - m_reg) <= 11.5f), 1)) { mn = m_reg; alpha = 1.f; }
    else { mn = fmaxf(m_reg, pmax); alpha = __builtin_amdgcn_exp2f(m_reg - mn); m_reg = mn; moved = true; }
    const float msub = mn - coff;
#pragma unroll
    for (int r = 0; r < 16; ++r) p0[r] = __builtin_amdgcn_exp2f(p0[r] - msub);
#pragma unroll
    for (int r = 0; r < 16; ++r) p1[r] = __builtin_amdgcn_exp2f(p1[r] - msub);
    float sm[8];
#pragma unroll
    for (int r = 0; r < 8; ++r) sm[r] = (p0[r] + p0[r + 8]) + (p1[r] + p1[r + 8]);
    float ps = ((sm[0] + sm[1]) + (sm[2] + sm[3])) + ((sm[4] + sm[5]) + (sm[6] + sm[7]));
    { auto rr = __builtin_amdgcn_permlane32_swap(__float_as_uint(ps), __float_as_uint(ps), false, false);
      ps = __uint_as_float(rr[0]) + __uint_as_float(rr[1]); }
    l_reg = l_reg * alpha + ps;
#define FA_PK4(P, B_, OUT) do { unsigned a0 = cvtpk(P[B_+0], P[B_+1]), a1 = cvtpk(P[B_+2], P[B_+3]);                          \
        unsigned b0 = cvtpk(P[B_+4], P[B_+5]), b1 = cvtpk(P[B_+6], P[B_+7]);                                             \
        auto r0 = __builtin_amdgcn_permlane32_swap(a0, b0, false, false); auto r1 = __builtin_amdgcn_permlane32_swap(a1, b1, false, false); \
        u32x4 w = {r0[0], r1[0], r0[1], r1[1]}; OUT = *reinterpret_cast<bf16x8*>(&w); } while (0)
    FA_PK4(p0, 0, pa0); FA_PK4(p0, 8, pa1); FA_PK4(p1, 0, pa2); FA_PK4(p1, 8, pa3);
#undef FA_PK4
    return moved;
}

__device__ __forceinline__ void softmax_fast(f32x16& p0, f32x16& p1, float& l_reg, bf16x8& pa0, bf16x8& pa1, bf16x8& pa2, bf16x8& pa3) {
#pragma unroll
    for (int r = 0; r < 16; ++r) p0[r] = __builtin_amdgcn_exp2f(p0[r]);
#pragma unroll
    for (int r = 0; r < 16; ++r) p1[r] = __builtin_amdgcn_exp2f(p1[r]);
    float sm[8];
#pragma unroll
    for (int r = 0; r < 8; ++r) sm[r] = (p0[r] + p0[r + 8]) + (p1[r] + p1[r + 8]);
    const float ps = ((sm[0] + sm[1]) + (sm[2] + sm[3])) + ((sm[4] + sm[5]) + (sm[6] + sm[7]));
    l_reg += ps;
#define FA_PK4(P, B_, OUT) do { unsigned a0 = cvtpk(P[B_+0], P[B_+1]), a1 = cvtpk(P[B_+2], P[B_+3]);                          \
        unsigned b0 = cvtpk(P[B_+4], P[B_+5]), b1 = cvtpk(P[B_+6], P[B_+7]);                                             \
        auto r0 = __builtin_amdgcn_permlane32_swap(a0, b0, false, false); auto r1 = __builtin_amdgcn_permlane32_swap(a1, b1, false, false); \
        u32x4 w = {r0[0], r1[0], r0[1], r1[1]}; OUT = *reinterpret_cast<bf16x8*>(&w); } while (0)
    FA_PK4(p0, 0, pa0); FA_PK4(p0, 8, pa1); FA_PK4(p1, 0, pa2); FA_PK4(p1, 8, pa3);
#undef FA_PK4
}

template <int MODE, bool SAFE>
__device__ __forceinline__ bool attn_unit_impl(const Frame& F, int l, int lane_in, int wid, int b, int h, int qb, unsigned* qctr, volatile LAS unsigned* qslot, int rs, int ro, int gp) {
    int lane = lane_in; asm volatile("" : "+v"(lane));
    constexpr int QB = (MODE == 3) ? 128 : 256;
    constexpr int NQ = (MODE == 0) ? 12 : (MODE == 3) ? 4 : 8;
    constexpr bool TABLE = MODE != 0, BITS = MODE == 2, ROPE = MODE == 0, WIN = (MODE == 1 || MODE == 4);
    constexpr float C2 = ((MODE == 0) ? 0.07216878364870323f : (MODE == 3) ? 0.125f : 0.08838834764831845f) * LOG2E;
    const int tid = wid * 64 + lane, r32 = lane & 31, hi = lane >> 5;
    WS_LOCAL
    const int rb = b * 4096, q0 = qb * QB;
    const int map = (MODE == 3) ? (wid >> 2) : 0;
    const int qlo = q0 + ((MODE == 3) ? (wid & 3) * 32 : wid * 32);
    LAS char* const lds = (LAS char*)F.lds;
    LAS char* const V_lds = lds + L_V; LAS char* const K_lds = lds + L_K; LAS char* const KR_lds = lds + L_KR;
    LAS float* const li_l = (LAS float*)(lds + L_WS) + wid * 64; LAS float* const al_l = li_l + 32;
    LAS float* const tab = (LAS float*)(lds + L_TAB);
    const bf16_t* Qp; const bf16_t* Kp; const bf16_t* Vp; const bf16_t* KRp = nullptr; int kpitch;
    if (MODE == 0) { Qp = WSP(bf16_t, WS_QA) + (size_t)(rb + qlo + r32) * 768 + h * 192 + hi * 8; Kp = WSP(bf16_t, WS_KVA) + (size_t)rb * 1024 + h * 256; Vp = Kp + 128; KRp = WSP(bf16_t, WS_KR) + (size_t)rb * 64; kpitch = 1024; }
    else { const bf16_t* base = WSP(bf16_t, WS_QKV) + (size_t)((MODE == 2 ? 1 : MODE == 3 ? 2 : 0) * 3) * M * 512;
        const int rs_ = WIN ? rs : 1, ro_ = WIN ? ro : 0;
        Qp = base + (size_t)(rb + rs_ * (qlo + r32) + ro_) * 512 + h * 128 + map * 64 + hi * 8; Kp = base + (size_t)M * 512 + (size_t)(rb + ro_) * 512 + h * 128; Vp = base + (size_t)2 * M * 512 + (size_t)(rb + ro_) * 512 + h * 128; kpitch = 512 * rs_; }
    bf16x8 qr[NQ];
#pragma unroll
    for (int i = 0; i < NQ; ++i) qr[i] = *(const bf16x8*)(Qp + i * 16);
    const int j_hi = (q0 + QB - 1) / 64 + 1;
    const int j_lo = WIN ? ((q0 > 128) ? ((q0 - 128) >> 6) : 0) : 0;
    const int NT = j_hi - j_lo;
    float tv[9];
    if (TABLE) {
        const float* Tg = WIN ? WSP(float, WS_TB) + (gp * 4 + h) * 192 : WSP(float, WS_TCD) + ((MODE == 3 ? 4 : 0) + h) * 4096;
#pragma unroll
        for (int q = 0; q < 9; ++q) { const int d = 4095 - (tid + q * NWAVES * 64); const bool ok = d >= 0 && (!WIN || d <= 128); const float v = Tg[ok ? d : 0]; tv[q] = ok ? v : -__builtin_inff(); }
    }
    const int sr = tid >> 4, sc = (tid & 15) * 8, vst0 = v_st(sr, sc), vst1 = v_st(32 + sr, sc), kws = FA_KSWZ(sr, sc * 2);
    const int krow = tid >> 3, kch = tid & 7, krws = FA_KRSWZ(krow, kch * 16);
    const int vb0 = (int)(unsigned)(size_t)V_lds + v_rd_base(lane);
    const unsigned long long* bmp = WSP(unsigned long long, WS_BM) + (size_t)(rb + qlo + r32) * 64;
    bf16x8 st_k0, st_k1, st_v0, st_v1, st_kr; unsigned long long bm_cur = 0ull, bm_nxt = 0ull;
#define FA_STAGE_LOAD(k0_) do { const bf16_t* kp_ = Kp + (size_t)((k0_) + sr) * kpitch + sc; const bf16_t* vp_ = Vp + (size_t)((k0_) + sr) * kpitch + sc; \
        st_k0 = *(const bf16x8*)kp_; st_k1 = *(const bf16x8*)(kp_ + (size_t)32 * kpitch); st_v0 = *(const bf16x8*)vp_; st_v1 = *(const bf16x8*)(vp_ + (size_t)32 * kpitch); \
        if (ROPE) st_kr = *(const bf16x8*)(KRp + (size_t)((k0_) + krow) * 64 + kch * 8); if (BITS) bm_nxt = bmp[(k0_) >> 6]; } while (0)
#define FA_STAGE_WRITE(kbf, vbf) do { *(LAS bf16x8*)(K_lds + (kbf) * SHM_K + kws) = st_k0; *(LAS bf16x8*)(K_lds + (kbf) * SHM_K + kws + 32 * 256) = st_k1; \
        *(LAS bf16x8*)(V_lds + (vbf) * SHM_V + vst0) = st_v0; *(LAS bf16x8*)(V_lds + (vbf) * SHM_V + vst1) = st_v1; if (ROPE) *(LAS bf16x8*)(KR_lds + (kbf) * SHM_KR + krws) = st_kr; } while (0)
    float m_reg = SAFE ? -1e30f : 0.f, l_reg = 0.f; f32x16 o[4] = {};
    volatile LAS unsigned* const badp = (volatile LAS unsigned*)(F.lds + MISC_OFF) + 20;
    if (!SAFE && tid == 0) *badp = 0u;
    const bool grpB = false;
    FA_STAGE_LOAD(j_lo * 64);
    {
#pragma unroll
        for (int i = 0; i < NQ; ++i) { u32x4 w = __builtin_bit_cast(u32x4, qr[i]);
            w.x = cvtpk(bf_lo(w.x) * C2, bf_hi(w.x) * C2); w.y = cvtpk(bf_lo(w.y) * C2, bf_hi(w.y) * C2); w.z = cvtpk(bf_lo(w.z) * C2, bf_hi(w.z) * C2); w.w = cvtpk(bf_lo(w.w) * C2, bf_hi(w.w) * C2);
            qr[i] = __builtin_bit_cast(bf16x8, w); }
    }
    if (TABLE) {
#pragma unroll
        for (int q = 0; q < 9; ++q) { const int i = tid + q * NWAVES * 64; if (i < TAB_N) tab[i] = tv[q]; }
    }
    asm volatile("s_waitcnt vmcnt(0)" ::: "memory"); FA_STAGE_WRITE(0, 0); bm_cur = bm_nxt;
    __syncthreads();
    float alpha = 1.f; bf16x8 pa0 = {}, pa1 = {}, pa2 = {}, pa3 = {};
    bool far_open = false;
    int vbc = 0, vbp = 2;
    bool act_prev = false;
#pragma unroll 1
    for (int t = 0; t < NT; ++t) {
        const int k0 = (j_lo + t) * 64; const bool more = t + 1 < NT; const int kb = t & 1; const int vbn = (vbc == NVB - 1) ? 0 : vbc + 1;
        if (more) FA_STAGE_LOAD(k0 + 64);
        if (grpB && act_prev) { pv_tile(o, vb0 + vbp * SHM_V, pa0, pa1, pa2, pa3); FA_SBAR(); }
        const bool act = (k0 <= qlo + 31) && (!WIN || k0 + 63 >= qlo - 128);
        if (act) {
        f32x16 p0 = {}, p1 = {};
        __builtin_amdgcn_s_setprio(1);
        if (MODE == 3) { if (map == 0) qkt_main<0, 4>(p0, p1, K_lds + kb * SHM_K, r32, hi, qr); else qkt_main<4, 4>(p0, p1, K_lds + kb * SHM_K, r32, hi, qr); }
        else qkt_main<0, 8>(p0, p1, K_lds + kb * SHM_K, r32, hi, qr);
        if (ROPE) qkt_rope(p0, p1, KR_lds + kb * SHM_KR, r32, hi, qr + (ROPE ? 8 : 0));
        __builtin_amdgcn_s_setprio(0);
        const int dq = qlo + r32 - k0 - 4 * hi;
        float coff = 0.f;
        if (TABLE) {
            if (!WIN && qlo - (k0 + 63) >= 1513) { coff = tab[0];
                far_open = true; }
            else {
                if (!SAFE && far_open) { far_open = false; const float kap = __builtin_amdgcn_exp2f(tab[0]); l_reg *= kap;
#pragma unroll
                    for (int d_ = 0; d_ < 4; ++d_)
#pragma unroll
                        for (int r = 0; r < 16; ++r) o[d_][r] *= kap; }
                const LAS float* tp = tab + (4095 - dq);
#pragma unroll
                for (int r = 0; r < 16; ++r) { const int c = (r & 3) + 8 * (r >> 2); p0[r] += tp[c]; p1[r] += tp[c + 32]; } }
            if (BITS) { const unsigned wlo = (unsigned)bm_cur >> (4 * hi), whi = (unsigned)(bm_cur >> 32) >> (4 * hi);
#pragma unroll
                for (int r = 0; r < 16; ++r) { const int c = (r & 3) + 8 * (r >> 2);
                    const unsigned m0_ = (unsigned)__builtin_amdgcn_sbfe(wlo, c, 1), m1_ = (unsigned)__builtin_amdgcn_sbfe(whi, c, 1);
                    p0[r] = __uint_as_float((__float_as_uint(p0[r]) & m0_) | (0xFF800000u & ~m0_)); p1[r] = __uint_as_float((__float_as_uint(p1[r]) & m1_) | (0xFF800000u & ~m1_)); } }
        } else {
            if (k0 + 63 > qlo) {
#pragma unroll
                for (int r = 0; r < 16; ++r) { const int c = (r & 3) + 8 * (r >> 2);
                    if (dq - c < 0) p0[r] = -__builtin_inff(); if (dq - c - 32 < 0) p1[r] = -__builtin_inff(); } }
        }
        if (SAFE) {
        const bool moved = softmax_tile(p0, p1, m_reg, l_reg, alpha, pa0, pa1, pa2, pa3, coff);
        if (moved) { if (hi == 0) al_l[r32] = alpha; asm volatile("s_waitcnt lgkmcnt(0)" ::: "memory");
#pragma unroll
            for (int r = 0; r < 16; ++r) { const float a_ = al_l[crow(r, hi)];
#pragma unroll
                for (int d_ = 0; d_ < 4; ++d_) o[d_][r] *= a_; } }
        } else softmax_fast(p0, p1, l_reg, pa0, pa1, pa2, pa3);
        FA_SBAR();
        if (!grpB) { pv_tile(o, vb0 + vbc * SHM_V, pa0, pa1, pa2, pa3); FA_SBAR(); }
        }
        act_prev = act;
        if (more) { asm volatile("s_waitcnt vmcnt(0)" ::: "memory"); FA_STAGE_WRITE(kb ^ 1, vbn); bm_cur = bm_nxt; }
        __syncthreads();
        vbp = vbc; vbc = vbn;
    }
    if (!SAFE) {
        auto rr = __builtin_amdgcn_permlane32_swap(__float_as_uint(l_reg), __float_as_uint(l_reg), false, false);
        l_reg = __uint_as_float(rr[0]) + __uint_as_float(rr[1]);
        if (__any(!(l_reg > 1e-30f && l_reg < 1e30f)) && lane == 0) *badp = 1u; }
    if (grpB && act_prev) pv_tile(o, vb0 + vbp * SHM_V, pa0, pa1, pa2, pa3);
    __syncthreads();
#undef FA_STAGE_LOAD
#undef FA_STAGE_WRITE
    if (!SAFE) { if (__builtin_amdgcn_readfirstlane((int)*badp) != 0) return true; }
    unsigned q_next = 0u; if (tid == 0) q_next = atomicAdd(qctr, 1u);
    u32x4 gv[8]; u32x4 p1v[8], p2v[8]; float e1 = 0.f, e2 = 0.f;
    if (MODE != 4 && (MODE != 3 || map == 0)) {
        const bf16_t* const Mr = WSP(bf16_t, WS_MIXED) + (size_t)(rb + qlo) * 2048 + (MODE == 1 ? 512 : MODE * 512) + h * 128;
#pragma unroll
        for (int i = 0; i < 8; ++i) { const int c = lane + 64 * i, row = c >> 4, col8 = (c & 15) * 8; gv[i] = *(const u32x4*)(Mr + (size_t)row * 2048 + col8); }
        if (MODE == 1) {
            const bf16_t* const P1 = WSP(bf16_t, WS_PB) + (size_t)(rb + qlo) * 512 + h * 128; const bf16_t* const P2 = P1 + (size_t)M * 512;
#pragma unroll
            for (int i = 0; i < 8; ++i) { const int c = lane + 64 * i, row = c >> 4, col8 = (c & 15) * 8; p1v[i] = *(const u32x4*)(P1 + (size_t)row * 512 + col8); p2v[i] = *(const u32x4*)(P2 + (size_t)row * 512 + col8); }
            const size_t rowg = (size_t)(rb + qlo + r32);
            e1 = WSP(float, WS_LSE)[rowg * 4 + h]; e2 = WSP(float, WS_LSE)[((size_t)M + rowg) * 4 + h];
        }
    }
    if (hi == 0) li_l[r32] = l_reg; asm volatile("s_waitcnt lgkmcnt(0)" ::: "memory");
    float rli[16];
#pragma unroll
    for (int r = 0; r < 16; ++r) rli[r] = __builtin_amdgcn_rcpf(li_l[crow(r, hi)]);
#pragma unroll
    for (int d0 = 0; d0 < 4; ++d0)
#pragma unroll
        for (int r = 0; r < 16; ++r) o[d0][r] *= rli[r];
    if (MODE == 3) {
        LAS float* xb = (LAS float*)lds + (size_t)(wid & 3) * 4096 + lane;
        if (map == 1) {
#pragma unroll
            for (int d0 = 0; d0 < 4; ++d0)
#pragma unroll
                for (int r = 0; r < 16; ++r) xb[(d0 * 16 + r) * 64] = o[d0][r];
        }
        __syncthreads();
        if (map == 0) {
            const float lam = WSP(float, WS_CONST)[l];
            const float li = (l == 0) ? 0.2f : 0.35550906759096926f;
#pragma unroll
            for (int d0 = 0; d0 < 4; ++d0)
#pragma unroll
                for (int r = 0; r < 16; ++r) o[d0][r] -= lam * xb[(d0 * 16 + r) * 64];
            const float* gs = FIN(15) + l * 128;
            float g4[4];
#pragma unroll
            for (int d0 = 0; d0 < 4; ++d0) g4[d0] = gs[d0 * 32 + r32] * (1.0f - li);
#pragma unroll
            for (int r = 0; r < 16; ++r) {
                float ss = (o[0][r] * o[0][r] + o[1][r] * o[1][r]) + (o[2][r] * o[2][r] + o[3][r] * o[3][r]);
                DPP_ADD(ss, 0xB1); DPP_ADD(ss, 0x4E); DPP_ADD(ss, 0x141); DPP_ADD(ss, 0x140);
                { auto rr_ = __builtin_amdgcn_permlane16_swap(__float_as_uint(ss), __float_as_uint(ss), false, false); ss = __uint_as_float(rr_[0]) + __uint_as_float(rr_[1]); }
                const float rs = __builtin_amdgcn_rsqf(ss * (1.0f / 128.0f) + 1e-6f);
#pragma unroll
                for (int d0 = 0; d0 < 4; ++d0) o[d0][r] *= rs * g4[d0];
            }
        }
    }
    if (MODE != 3 || map == 0) {
        LAS char* const stg = lds + ((MODE == 3) ? 65536 + wid * 8192 : wid * 8192);
#pragma unroll
        for (int r = 0; r < 16; ++r) { const int orow = crow(r, hi);
#pragma unroll
            for (int d0 = 0; d0 < 4; ++d0) { const float v = o[d0][r];
                const float vn = __builtin_bit_cast(float, __builtin_amdgcn_update_dpp(0, __builtin_bit_cast(int, v), 0xB1, 0xF, 0xF, true));
                if ((r32 & 1) == 0) *(LAS unsigned*)(stg + (orow * 128 + d0 * 32 + r32) * 2) = cvtpk(v, vn); } }
        if (MODE == 4) {
            asm volatile("s_waitcnt lgkmcnt(0)" ::: "memory");
            bf16_t* const Pw = WSP(bf16_t, WS_PB) + (size_t)(gp - 1) * M * 512 + h * 128;
#pragma unroll
            for (int i = 0; i < 8; ++i) { const int c = lane + 64 * i, row = c >> 4, col8 = (c & 15) * 8;
                *(u32x4*)(Pw + (size_t)(rb + rs * (qlo + row) + ro) * 512 + col8) = *(const LAS u32x4*)(stg + row * 256 + col8 * 2); }
            if (hi == 0) WSP(float, WS_LSE)[((size_t)(gp - 1) * M + (rb + rs * (qlo + r32) + ro)) * 4 + h] = m_reg + __builtin_amdgcn_logf(l_reg);
        } else if (MODE == 1) {
            LAS float* const wts = (LAS float*)(lds + 65536 + wid * 512);
            if (hi == 0) {
                const float e0 = m_reg + __builtin_amdgcn_logf(l_reg);
                const float mx = fmaxf(fmaxf(e0, e1), e2);
                const float w0 = __builtin_amdgcn_exp2f(e0 - mx), w1 = __builtin_amdgcn_exp2f(e1 - mx), w2 = __builtin_amdgcn_exp2f(e2 - mx);
                const float inv = __builtin_amdgcn_rcpf(w0 + w1 + w2);
                *(LAS f32x4*)(wts + r32 * 4) = (f32x4){w0 * inv, w1 * inv, w2 * inv, 0.f};
            }
            asm volatile("s_waitcnt lgkmcnt(0)" ::: "memory");
            bf16_t* const Mw = WSP(bf16_t, WS_MIXED) + (size_t)(rb + qlo) * 2048 + 512 + h * 128;
            u32x4 ov[8];
#pragma unroll
            for (int i = 0; i < 8; ++i) { const int c = lane + 64 * i, row = c >> 4, col8 = (c & 15) * 8; ov[i] = *(const LAS u32x4*)(stg + row * 256 + col8 * 2); }
#pragma unroll
            for (int i = 0; i < 8; ++i) { const int c = lane + 64 * i, row = c >> 4, col8 = (c & 15) * 8;
                const f32x4 w = *(const LAS f32x4*)(wts + row * 4);
#define FA_MIX(O, A, B, G, sel) ((w[0] * sel(O) + w[1] * sel(A) + w[2] * sel(B)) * sel(G))
                u32x4 q;
                q.x = cvtpk(FA_MIX(ov[i].x, p1v[i].x, p2v[i].x, gv[i].x, bf_lo), FA_MIX(ov[i].x, p1v[i].x, p2v[i].x, gv[i].x, bf_hi));
                q.y = cvtpk(FA_MIX(ov[i].y, p1v[i].y, p2v[i].y, gv[i].y, bf_lo), FA_MIX(ov[i].y, p1v[i].y, p2v[i].y, gv[i].y, bf_hi));
                q.z = cvtpk(FA_MIX(ov[i].z, p1v[i].z, p2v[i].z, gv[i].z, bf_lo), FA_MIX(ov[i].z, p1v[i].z, p2v[i].z, gv[i].z, bf_hi));
                q.w = cvtpk(FA_MIX(ov[i].w, p1v[i].w, p2v[i].w, gv[i].w, bf_lo), FA_MIX(ov[i].w, p1v[i].w, p2v[i].w, gv[i].w, bf_hi));
#undef FA_MIX
                *(u32x4*)(Mw + (size_t)row * 2048 + col8) = q; }
        } else {
        asm volatile("s_waitcnt lgkmcnt(0)" ::: "memory");
        bf16_t* const Mw = WSP(bf16_t, WS_MIXED) + (size_t)(rb + qlo) * 2048 + MODE * 512 + h * 128;
        u32x4 ov[8];
#pragma unroll
        for (int i = 0; i < 8; ++i) { const int c = lane + 64 * i, row = c >> 4, col8 = (c & 15) * 8; ov[i] = *(const LAS u32x4*)(stg + row * 256 + col8 * 2); }
#pragma unroll
        for (int i = 0; i < 8; ++i) { const int c = lane + 64 * i, row = c >> 4, col8 = (c & 15) * 8;
            u32x4 w;
            w.x = cvtpk(bf_lo(ov[i].x) * bf_lo(gv[i].x), bf_hi(ov[i].x) * bf_hi(gv[i].x)); w.y = cvtpk(bf_lo(ov[i].y) * bf_lo(gv[i].y), bf_hi(ov[i].y) * bf_hi(gv[i].y));
            w.z = cvtpk(bf_lo(ov[i].z) * bf_lo(gv[i].z), bf_hi(ov[i].z) * bf_hi(gv[i].z)); w.w = cvtpk(bf_lo(ov[i].w) * bf_lo(gv[i].w), bf_hi(ov[i].w) * bf_hi(gv[i].w));
            *(u32x4*)(Mw + (size_t)row * 2048 + col8) = w; }
        }
    }
    if (tid == 0) *qslot = q_next;
    __syncthreads();
    return false;
}
template <int MODE>
__device__ __forceinline__ void attn_unit(const Frame& F, int l, int lane_in, int wid, int b, int h, int qb, unsigned* qctr, volatile LAS unsigned* qslot, int rs = 1, int ro = 0, int gp = 0) {
    int bad = __builtin_amdgcn_readfirstlane(attn_unit_impl<MODE, false>(F, l, lane_in, wid, b, h, qb, qctr, qslot, rs, ro, gp) ? 1 : 0);
    asm volatile("" : "+s"(bad));
    if (__builtin_expect(bad != 0, 0)) {
        int b2 = b, h2 = h, qb2 = qb, rs2 = rs, ro2 = ro, gp2 = gp, w2 = wid, l2 = lane_in;
        asm volatile("" : "+s"(b2), "+s"(h2), "+s"(qb2), "+s"(rs2), "+s"(ro2), "+s"(gp2), "+s"(w2), "+v"(l2));
        __syncthreads();
        (void)attn_unit_impl<MODE, true>(F, l, l2, w2, b2, h2, qb2, qctr, qslot, rs2, ro2, gp2);
    }
}
#undef FA_KSWZ
#undef FA_KRSWZ
#undef FA_SBAR
}

__device__ __forceinline__ int queue_next(unsigned* ctr, volatile LAS unsigned* slot, int tid) {
    if (tid == 0) *slot = atomicAdd(ctr, 1u);
    __syncthreads();
    const int v = (int)*slot;
    __syncthreads();
    return v;
}
__device__ __forceinline__ void p_attn_group1(const Frame& F, int l) {
    PHASE_LOCALS
    unsigned* ctr = (unsigned*)(ws_l + WS_CTL + 16384 + (l * 4 + 3) * 256);
    volatile LAS unsigned* slot = (volatile LAS unsigned*)(F.lds + MISC_OFF) + 16;
    int it = queue_next(ctr, slot, tid);
    while (it < 1024) {
        const int bh = it & 15;
        if (it < 512) fa::attn_unit<3>(F, l, lane, wave, bh >> 2, bh & 3, 31 - (it >> 4), ctr, slot);
        else { const int j = it - 512; const bool p4 = j < 256;
            fa::attn_unit<4>(F, l, lane, wave, bh >> 2, bh & 3, p4 ? 3 - (j >> 6) : 0, ctr, slot, p4 ? 4 : 16, p4 ? (j >> 4) & 3 : (j - 256) >> 4, p4 ? 1 : 2); }
        it = (int)*slot;
    }
    __syncthreads();
}
__device__ __forceinline__ void p_attn_group2(const Frame& F, int l) {
    PHASE_LOCALS
    unsigned* ctr = (unsigned*)(ws_l + WS_CTL + 16384 + (l * 4 + 0) * 256);
    volatile LAS unsigned* slot = (volatile LAS unsigned*)(F.lds + MISC_OFF) + 16;
    int it = queue_next(ctr, slot, tid);
    while (it < 768) {
        const int bh = it & 15, qb = 15 - ((it >> 4) & 15);
        if (it < 256) fa::attn_unit<0>(F, l, lane, wave, bh >> 2, bh & 3, qb, ctr, slot);
        else if (it < 512) fa::attn_unit<2>(F, l, lane, wave, bh >> 2, bh & 3, qb, ctr, slot);
        else fa::attn_unit<1>(F, l, lane, wave, bh >> 2, bh & 3, qb, ctr, slot);
        it = (int)*slot;
    }
    __syncthreads();
}

namespace ix {
using fa::bf16x8; using fa::f32x16;
constexpr int KB = 3;
constexpr int L_Q = 0, L_W = 65536;
__device__ __forceinline__ void index_item(const Frame& F, int lane_in, int wid, int b, int qi, float* scr, int pitch  ) {
    int lane = lane_in; asm volatile("" : "+v"(lane));
    WS_LOCAL
    const int tid = wid * 64 + lane, r32 = lane & 31, hi = lane >> 5;
    const int rb = b * 4096, q0 = qi * 32;
    LAS char* const lds = (LAS char*)F.lds;
    {
        const int r = tid >> 4;
        const bf16_t* src = WSP(bf16_t, WS_IDXQ) + (size_t)(rb + q0 + r) * 1024;
#pragma unroll
        for (int i = 0; i < 8; ++i) { const int c = (tid & 15) + 16 * i; const bf16x8 v = *(const bf16x8*)(src + c * 8); *(LAS bf16x8*)(lds + L_Q + r * 2048 + ((c ^ (r & 15)) << 4)) = v; }
        ((LAS float*)(lds + L_W))[(tid & 15) * 32 + r] = WSP(float, WS_IDXW)[(size_t)(rb + q0 + r) * 16 + (tid & 15)];
    }
    __syncthreads();
    const int nkb = qi + 1;
    unsigned abase[4];
#pragma unroll
    for (int s = 0; s < 4; ++s) abase[s] = (unsigned)(size_t)(lds + L_Q) + r32 * 2048 + (((2 * s + hi) ^ (r32 & 15)) << 4);
    const bf16_t* kbase = WSP(bf16_t, WS_IDXK) + (size_t)(rb + r32) * 64 + 8 * hi;
    const LAS float* wrow = (const LAS float*)(lds + L_W) + r32;
#define IX_LDA(dst, hh) do { _Pragma("unroll") for (int s = 0; s < 4; ++s) dst[s] = *(const LAS bf16x8*)(size_t)((abase[s] ^ ((unsigned)((hh) & 1) << 7)) + (unsigned)((hh) >> 1) * 256u); } while (0)
#define IX_RELU(x) __int_as_float(max(__float_as_int(x), 0))
#define IX_BLKA(MMA, ACC, AH, WV) do { _Pragma("unroll") for (int s = 0; s < 4; ++s) { \
        if (MMA) { dA0 = __builtin_amdgcn_mfma_f32_32x32x16_bf16(kf[0][s], AH[s], s == 0 ? f32x16{} : dA0, 0, 0, 0); dA1 = __builtin_amdgcn_mfma_f32_32x32x16_bf16(kf[1][s], AH[s], s == 0 ? f32x16{} : dA1, 0, 0, 0); } \
        if (ACC) { _Pragma("unroll") for (int i = 4 * s; i < 4 * s + 4; ++i) score[2][i] = fmaf(IX_RELU(dB[i]), WV, score[2][i]); } } } while (0)
#define IX_BLKB(AH, WV) do { _Pragma("unroll") for (int s = 0; s < 4; ++s) { \
        dB = __builtin_amdgcn_mfma_f32_32x32x16_bf16(kf[2][s], AH[s], s == 0 ? f32x16{} : dB, 0, 0, 0); \
        _Pragma("unroll") for (int i = 4 * s; i < 4 * s + 4; ++i) { score[0][i] = fmaf(IX_RELU(dA0[i]), WV, score[0][i]); score[1][i] = fmaf(IX_RELU(dA1[i]), WV, score[1][i]); } } } while (0)
    for (int kb0 = wid * KB; kb0 < nkb; kb0 += NWAVES * KB) {
        bf16x8 kf[KB][4];
#pragma unroll
        for (int kbi = 0; kbi < KB; ++kbi)
#pragma unroll
            for (int s = 0; s < 4; ++s) { kf[kbi][s] = (bf16x8){0, 0, 0, 0, 0, 0, 0, 0}; if (kb0 + kbi < nkb) kf[kbi][s] = *(const bf16x8*)(kbase + (size_t)(kb0 + kbi) * 32 * 64 + 16 * s); }
        f32x16 score[KB];
#pragma unroll
        for (int kbi = 0; kbi < KB; ++kbi) score[kbi] = f32x16{};
        bf16x8 a0[4], a1[4]; f32x16 dA0, dA1, dB; float w0, w1;
        IX_LDA(a0, 0); w0 = wrow[0]; IX_LDA(a1, 1); w1 = wrow[32];
        IX_BLKA(true, false, a0, w0);
#pragma unroll 1
        for (int h = 0; h < 14; h += 2) {
            IX_BLKB(a0, w0);
            IX_LDA(a0, h + 2);
            IX_BLKA(true, true, a1, w0);
            w0 = wrow[(h + 2) * 32];
            IX_BLKB(a1, w1);
            IX_LDA(a1, h + 3);
            IX_BLKA(true, true, a0, w1);
            w1 = wrow[(h + 3) * 32];
        }
        IX_BLKB(a0, w0);
        IX_BLKA(true, true, a1, w0);
        IX_BLKB(a1, w1);
        IX_BLKA(false, true, a0, w1);
        int kbs = kb0, pit = pitch; asm volatile("" : "+s"(kbs), "+s"(pit));
#pragma unroll
        for (int kbi = 0; kbi < KB; ++kbi) {
            if (kbs + kbi < nkb) {
                float* dst = scr + (size_t)r32 * pit + (size_t)(kbs + kbi) * 32 + 4 * hi;
#pragma unroll
                for (int g = 0; g < 4; ++g) *(f32x4*)(dst + 8 * g) = (f32x4){score[kbi][4 * g], score[kbi][4 * g + 1], score[kbi][4 * g + 2], score[kbi][4 * g + 3]};
            }
        }
    }
#undef IX_LDA
#undef IX_RELU
#undef IX_BLKA
#undef IX_BLKB
    asm volatile("s_waitcnt vmcnt(0)" ::: "memory");
    __syncthreads();
    __builtin_amdgcn_fence(__ATOMIC_ACQUIRE, "agent");
    asm volatile("s_waitcnt vmcnt(0)" ::: "memory");
#pragma unroll 1
    for (int rr = 0; rr < 4; ++rr) {
        const int row = wid * 4 + rr, pos = q0 + row;
        const float* srow = scr + (size_t)(row * pitch) + lane;
        const int js = pos >> 6;
        float sv[64];
#pragma unroll
        for (int g = 0; g < 8; ++g) {
            if (64 * 8 * g <= pos) {
#pragma unroll
                for (int q = 0; q < 8; ++q) sv[8 * g + q] = srow[64 * (8 * g + q)];
            } else {
#pragma unroll
                for (int q = 0; q < 8; ++q) sv[8 * g + q] = 0.f;
            }
        }
        unsigned uk[64];
#pragma unroll
        for (int g = 0; g < 8; ++g) {
            if (8 * g + 7 < js) {
#pragma unroll
                for (int j = 8 * g; j < 8 * g + 8; ++j) uk[j] = score_key(sv[j]);
            } else if (8 * g <= js) {
#pragma unroll
                for (int j = 8 * g; j < 8 * g + 8; ++j) uk[j] = (64 * j + lane <= pos) ? score_key(sv[j]) : 0u;
            } else {
#pragma unroll
                for (int j = 8 * g; j < 8 * g + 8; ++j) uk[j] = 0u;
            }
        }
        select_row(uk, pos, WSP(unsigned long long, WS_BM) + (size_t)(rb + pos) * 64, lane, (LAS unsigned*)(lds + L_W + 4096) + wid * 64);
    }
    __syncthreads();
}
}
__device__ __forceinline__ void p_index_fast(const Frame& F) {
    PHASE_LOCALS
    for (int w = bid; w < 256; w += G_l) {
    const int a = (w >> 2) & 63, b = w & 3, nkbig = 128 - a;
    float* scr = (float*)(ws_l + WS_SCR + (size_t)16384 * (128 * a - (a * (a - 1)) / 2) + (size_t)b * nkbig * 4096);
    ix::index_item(F, lane, wave, b, 127 - a, scr, 32 * nkbig);
    ix::index_item(F, lane, wave, b, a, scr, 32 * nkbig);
    }
}
template <int PH_LO, int PH_HI>
__global__ void __launch_bounds__(NWAVES * 64, 2) fwd_kernel(Args args) {
    extern __shared__ __attribute__((aligned(16))) unsigned char lds_raw[];
    Frame F;
    F.lds = (LAS unsigned char*)lds_raw;
    F.wave = __builtin_amdgcn_readfirstlane((int)threadIdx.x >> 6);
    F.G = gridDim.x; { const int bx = blockIdx.x; F.vcu = (F.G % 8 == 0) ? (bx % 8) * (F.G / 8) + bx / 8 : bx; }
    F.a = &args; F.out = args.out; F.ws = args.ws;
    volatile LAS unsigned* MISC = (volatile LAS unsigned*)(F.lds + MISC_OFF);
    if (threadIdx.x < 64) MISC[threadIdx.x] = 0u;
    __syncthreads();
    constexpr int lo = PH_LO, hi = PH_HI;
    constexpr bool use_bar = (hi - lo) > 1;
    XcdBarrier bar; bar.bar = (unsigned*)(F.ws + WS_CTL); bar.x = 0; bar.st = MISC + 8;
    if (use_bar) bar = xcd_barrier_post((unsigned*)(F.ws + WS_CTL), MISC + 8);
    bar.wave0 = F.wave;
#define IN(k) (lo <= (k) && (k) < hi)
#define SEAM(k) do { if constexpr (IN(k) && IN((k) + 1)) { XcdBarrier b2_ = bar; asm volatile("" : "+s"(b2_.bar), "+s"(b2_.x)); xcd_barrier(b2_); } } while (0)
    if constexpr (IN(0)) { p0_prologue(F); } SEAM(0);
    if constexpr (IN(1)) { p_pre0(F); } SEAM(1);
#define LAYER_PHASES(l_)                                                                                                                                      \
    { constexpr int l = (l_); constexpr int pb = 2 + 5 * l;                                                                                                    \
        if constexpr (IN(pb))     { p_gemm1(F, l); } SEAM(pb);                                                                           \
        if constexpr (IN(pb + 1)) { p_upq(F, l); __syncthreads(); p_upkv(F, l); __syncthreads(); p_index_fast(F); __syncthreads();                             \
                                    p_attn_group1(F, l); } SEAM(pb + 1);                        \
        if constexpr (IN(pb + 2)) { p_attn_group2(F, l); } SEAM(pb + 2);                                          \
        if constexpr (IN(pb + 3)) { p_gemm2(F, l); } SEAM(pb + 3);                                                                      \
        if constexpr (IN(pb + 4)) { p_post(F, l); } SEAM(pb + 4);                                                        \
    }
    LAYER_PHASES(0)
    LAYER_PHASES(1)
}

extern "C" void kernel_launch(void* const* d_in, const int* in_sizes, int n_in, void* d_out, int out_size, void* d_ws, size_t ws_size, hipStream_t stream) {
    static int grid = 0;
    if (grid == 0) {
        if (n_in != 18 || out_size != M * DM || ws_size < WS_END) { fprintf(stderr, "kernel_launch: unexpected problem (n_in %d, out %d, ws %zu < %zu)\n", n_in, out_size, ws_size, (size_t)WS_END); grid = -1; return; }
        int dev = 0, cus = 0, per_cu = 0;
        if (hipGetDevice(&dev) != hipSuccess || hipDeviceGetAttribute(&cus, hipDeviceAttributeMultiprocessorCount, dev) != hipSuccess) { grid = -1; return; }
        if (hipFuncSetAttribute((const void*)fwd_kernel<0, N_PHASES>, hipFuncAttributeMaxDynamicSharedMemorySize, LDS_BYTES) != hipSuccess) { fprintf(stderr, "kernel_launch: hipFuncSetAttribute failed\n"); grid = -1; return; }
        if (hipOccupancyMaxActiveBlocksPerMultiprocessor(&per_cu, (const void*)fwd_kernel<0, N_PHASES>, NWAVES * 64, LDS_BYTES) != hipSuccess || per_cu < 1) { fprintf(stderr, "kernel_launch: occupancy query reports %d\n", per_cu); }
        (void)hipGetLastError();
        grid = cus;
    }
    if (grid < 0) return;
    if (hipMemsetAsync((char*)d_ws, 0, ZERO_BYTES, stream) != hipSuccess) { fprintf(stderr, "kernel_launch: memset failed\n"); return; }
    Args a{};
    for (int i = 0; i < 18; ++i) a.in[i] = (const float*)d_in[i];
    a.out = (float*)d_out; a.ws = (unsigned char*)d_ws;
    a.ph_lo = 0; a.ph_hi = N_PHASES;
    hipLaunchKernelGGL((fwd_kernel<0, N_PHASES>), dim3(grid), dim3(NWAVES * 64), LDS_BYTES, stream, a);
    const hipError_t le = hipPeekAtLastError();
    if (le != hipSuccess) fprintf(stderr, "kernel_launch: launch failed: %s\n", hipGetErrorName(le));
}
```
